# Optimizing an MI355X kernel written in HIP

```python
import math
import jax, jax.numpy as jnp
from jax import lax
import numpy as np

D_MODEL = 2048
BATCH = 1
SEQ = 8192
DEPTH = 4

PE_DIM = 256
ATTN_HEADS = 8
ATTN_HEAD_DIM = 128
ATTN_WIDTH = ATTN_HEADS * ATTN_HEAD_DIM
MOBA_BLOCK = 256
MOBA_TOPK = 3
Q_CHUNK = 128
ROPE_DIM = ATTN_HEAD_DIM // 4
ROPE_THETA = 500000.0
SSD_WIDTH = D_MODEL - ATTN_WIDTH
SSD_HEAD_DIM = 64
SSD_HEADS = SSD_WIDTH // SSD_HEAD_DIM
SSD_GROUPS = 2
SSD_HEADS_PER_GROUP = SSD_HEADS // SSD_GROUPS
SSD_STATE = 128
SSD_CONV = 4
SSD_CHUNK = 256
SSD_CONV_DIM = SSD_WIDTH + 2 * SSD_GROUPS * SSD_STATE
MIX_WIDTH = ATTN_WIDTH + SSD_WIDTH
IN_PROJ_DIM = 3 * ATTN_WIDTH + SSD_WIDTH + SSD_CONV_DIM + SSD_HEADS
D_FF = 5632
FFN_CONV = 3
DEEPNORM_ALPHA = (2 * DEPTH) ** 0.25
DEEPNORM_BETA = (8 * DEPTH) ** -0.25
LN_EPS = 1e-5
RMS_EPS = 1e-6

kernel_name = "hybrid_moba_ssd_convffn_deepnorm"


def layer_norm(x, g, b):
    xf = x.astype(jnp.float32)
    mu = jnp.mean(xf, -1, keepdims=True)
    var = jnp.mean(jnp.square(xf - mu), -1, keepdims=True)
    return ((xf - mu) * lax.rsqrt(var + LN_EPS) * g + b).astype(x.dtype)


def rms_norm(x, g):
    xf = x.astype(jnp.float32)
    return (xf * lax.rsqrt(jnp.mean(xf * xf, -1, keepdims=True) + RMS_EPS) * g).astype(x.dtype)


def causal_depthwise_conv(x, w):
    K = w.shape[0]
    S = x.shape[1]
    xp = jnp.pad(x, ((0, 0), (K - 1, 0), (0, 0)))
    return sum(xp[:, k:k + S] * w[k] for k in range(K))


def partial_rope(t, positions):
    half = ROPE_DIM // 2
    inv_freq = 1.0 / (ROPE_THETA ** (jnp.arange(0, ROPE_DIM, 2, dtype=jnp.float32) / ROPE_DIM))
    ang = positions.astype(jnp.float32)[..., None] * inv_freq
    cos = jnp.cos(ang)[:, :, None, :]
    sin = jnp.sin(ang)[:, :, None, :]
    tf = t.astype(jnp.float32)
    t1, t2, rest = tf[..., :half], tf[..., half:ROPE_DIM], tf[..., ROPE_DIM:]
    out = jnp.concatenate([t1 * cos - t2 * sin, t2 * cos + t1 * sin, rest], -1)
    return out.astype(t.dtype)


def moba_attention(q, k, v):
    B, S, H, Dh = q.shape
    nb = -(-S // MOBA_BLOCK)
    sp = nb * MOBA_BLOCK
    topk = min(MOBA_TOPK, nb)
    scale = Dh ** -0.5
    qh = q.transpose(0, 2, 1, 3)
    pad = ((0, 0), (0, 0), (0, sp - S), (0, 0))
    kb = jnp.pad(k.transpose(0, 2, 1, 3), pad).reshape(B, H, nb, MOBA_BLOCK, Dh)
    vb = jnp.pad(v.transpose(0, 2, 1, 3), pad).reshape(B, H, nb, MOBA_BLOCK, Dh)
    k_mean = jnp.mean(kb.astype(jnp.float32), axis=3)
    q_blk = jnp.arange(S) // MOBA_BLOCK
    gate = jnp.einsum('bhsd,bhnd->bhsn', qh.astype(jnp.float32), k_mean)
    eligible = jnp.arange(nb)[None, :] < q_blk[:, None]
    gate = jnp.where(eligible, gate, -jnp.inf)
    _, sel = lax.top_k(gate, topk)
    valid = jnp.arange(topk)[None, :] < q_blk[:, None]
    bi = jnp.arange(B)[:, None, None, None]
    hi = jnp.arange(H)[None, :, None, None]
    n_chunks = S // Q_CHUNK
    sel_len = topk * MOBA_BLOCK

    def chunk(c):
        q0 = c * Q_CHUNK
        qc = lax.dynamic_slice_in_dim(qh, q0, Q_CHUNK, axis=2)
        sc = lax.dynamic_slice_in_dim(sel, q0, Q_CHUNK, axis=2)
        vc = lax.dynamic_slice_in_dim(valid, q0, Q_CHUNK, axis=0)
        own = q0 // MOBA_BLOCK
        k_own = lax.dynamic_index_in_dim(kb, own, axis=2, keepdims=False)
        v_own = lax.dynamic_index_in_dim(vb, own, axis=2, keepdims=False)
        k_sel = kb[bi, hi, sc]
        v_sel = vb[bi, hi, sc]
        s_sel = jnp.einsum('bhqd,bhqtkd->bhqtk', qc, k_sel).astype(jnp.float32) * scale
        s_sel = jnp.where(vc[None, None, :, :, None], s_sel, -jnp.inf)
        s_own = jnp.einsum('bhqd,bhkd->bhqk', qc, k_own).astype(jnp.float32) * scale
        q_pos = q0 + jnp.arange(Q_CHUNK)
        k_pos = own * MOBA_BLOCK + jnp.arange(MOBA_BLOCK)
        s_own = jnp.where(k_pos[None, :] <= q_pos[:, None], s_own, -jnp.inf)
        scores = jnp.concatenate([s_sel.reshape(B, H, Q_CHUNK, sel_len), s_own], -1)
        probs = jax.nn.softmax(scores, axis=-1).astype(v.dtype)
        p_sel = probs[..., :sel_len].reshape(B, H, Q_CHUNK, topk, MOBA_BLOCK)
        p_own = probs[..., sel_len:]
        return (jnp.einsum('bhqtk,bhqtkd->bhqd', p_sel, v_sel)
                + jnp.einsum('bhqk,bhkd->bhqd', p_own, v_own))

    out = lax.map(chunk, jnp.arange(n_chunks))
    return out.transpose(1, 0, 3, 2, 4).reshape(B, S, H * Dh)


def ssd_mixer(z, xbc, dt_raw, conv_w, conv_b, dt_bias, a_log, d_skip, norm_g):
    B, S, _ = xbc.shape
    G, E, P, N, L = SSD_GROUPS, SSD_HEADS_PER_GROUP, SSD_HEAD_DIM, SSD_STATE, SSD_CHUNK
    xbc = jax.nn.silu(causal_depthwise_conv(xbc, conv_w) + conv_b)
    xs, b_in, c_in = jnp.split(xbc, [SSD_WIDTH, SSD_WIDTH + G * N], axis=-1)
    dt = jax.nn.softplus(dt_raw.astype(jnp.float32) + dt_bias)
    a = -jnp.exp(a_log.astype(jnp.float32))
    nc = -(-S // L)
    sp = nc * L

    def pad_s(t):
        return jnp.pad(t, ((0, 0), (0, sp - S)) + ((0, 0),) * (t.ndim - 2))

    x5 = pad_s(xs).reshape(B, nc, L, G, E, P).astype(jnp.float32)
    dt5 = pad_s(dt).reshape(B, nc, L, G, E)
    bm = pad_s(b_in).reshape(B, nc, L, G, N).astype(jnp.float32)
    cm = pad_s(c_in).reshape(B, nc, L, G, N).astype(jnp.float32)
    xdt = x5 * dt5[..., None]
    a_cs = jnp.cumsum((dt5 * a.reshape(G, E)).transpose(0, 3, 4, 1, 2), axis=-1)
    tril = jnp.tril(jnp.ones((L, L), dtype=bool))
    seg = jnp.exp(jnp.where(tril, a_cs[..., :, None] - a_cs[..., None, :], -jnp.inf))
    cb = jnp.einsum('bclgn,bcsgn->bcgls', cm, bm)
    y_diag = jnp.einsum('bcgls,bgecls,bcsgep->bclgep', cb, seg, xdt)
    decay_states = jnp.exp(a_cs[..., -1:] - a_cs)
    states = jnp.einsum('bclgn,bgecl,bclgep->cbgepn', bm, decay_states, xdt)
    chunk_decay = jnp.exp(a_cs[..., -1]).transpose(3, 0, 1, 2)

    def step(h, inp):
        s_c, d_c = inp
        return d_c[..., None, None] * h + s_c, h

    _, states_in = lax.scan(step, jnp.zeros(states.shape[1:], jnp.float32), (states, chunk_decay))
    y_off = jnp.einsum('bclgn,cbgepn,bgecl->bclgep', cm, states_in, jnp.exp(a_cs))
    y = y_diag + y_off + x5 * d_skip.astype(jnp.float32).reshape(G, E)[:, :, None]
    y = y.reshape(B, sp, SSD_WIDTH)[:, :S]
    yg = (y * jax.nn.silu(z.astype(jnp.float32))).reshape(B, S, G, SSD_WIDTH // G)
    yg = yg * lax.rsqrt(jnp.mean(yg * yg, -1, keepdims=True) + RMS_EPS)
    return (yg.reshape(B, S, SSD_WIDTH) * norm_g).astype(z.dtype)


def conv_ffn(x, w_up, conv_w, conv_b, w_down):
    h = causal_depthwise_conv(x @ w_up, conv_w) + conv_b
    g, u = jnp.split(h, 2, axis=-1)
    return (jax.nn.silu(g) * u) @ w_down


def setup_inputs(seed: int = 0) -> dict:
    key = jax.random.key(seed)
    ks = jax.random.split(key, 24)
    nrm = jax.random.normal
    f32 = jnp.float32
    x = nrm(ks[0], (BATCH, SEQ, D_MODEL), f32)
    p = nrm(ks[1], (DEPTH, BATCH, SEQ, PE_DIM), f32)
    positions = jnp.broadcast_to(jnp.arange(SEQ, dtype=jnp.int32)[None, :], (BATCH, SEQ))
    w_in = nrm(ks[2], (DEPTH, D_MODEL, IN_PROJ_DIM), f32) * D_MODEL ** -0.5
    attn_norm_g = 1.0 + 0.02 * nrm(ks[3], (DEPTH, ATTN_WIDTH), f32)
    ssd_conv_w = nrm(ks[4], (DEPTH, SSD_CONV, SSD_CONV_DIM), f32) * SSD_CONV ** -0.5
    ssd_conv_b = 0.02 * nrm(ks[5], (DEPTH, SSD_CONV_DIM), f32)
    dt0 = jnp.exp(jax.random.uniform(ks[6], (DEPTH, SSD_HEADS), f32, math.log(1e-3), math.log(1e-1)))
    ssd_dt_bias = dt0 + jnp.log(-jnp.expm1(-dt0))
    ssd_a_log = jnp.log(jax.random.uniform(ks[7], (DEPTH, SSD_HEADS), f32, 1.0, 16.0))
    ssd_d = 1.0 + 0.1 * nrm(ks[8], (DEPTH, SSD_HEADS), f32)
    ssd_norm_g = 1.0 + 0.02 * nrm(ks[9], (DEPTH, SSD_WIDTH), f32)
    w_out = nrm(ks[10], (DEPTH, MIX_WIDTH, D_MODEL), f32) * MIX_WIDTH ** -0.5 * DEEPNORM_BETA
    ln1_g = 1.0 + 0.02 * nrm(ks[11], (DEPTH, D_MODEL), f32)
    ln1_b = 0.02 * nrm(ks[12], (DEPTH, D_MODEL), f32)
    w_up = nrm(ks[13], (DEPTH, D_MODEL, 2 * D_FF), f32) * D_MODEL ** -0.5
    ffn_conv_w = nrm(ks[14], (DEPTH, FFN_CONV, 2 * D_FF), f32) * FFN_CONV ** -0.5
    ffn_conv_b = 0.02 * nrm(ks[15], (DEPTH, 2 * D_FF), f32)
    w_down = nrm(ks[16], (DEPTH, D_FF, D_MODEL), f32) * D_FF ** -0.5 * DEEPNORM_BETA
    w_pe_gate = nrm(ks[17], (DEPTH, D_MODEL, D_MODEL), f32) * D_MODEL ** -0.5
    w_pe_proj = nrm(ks[18], (DEPTH, PE_DIM, D_MODEL), f32) * PE_DIM ** -0.5 * DEEPNORM_BETA
    ln2_g = 1.0 + 0.02 * nrm(ks[19], (DEPTH, D_MODEL), f32)
    ln2_b = 0.02 * nrm(ks[20], (DEPTH, D_MODEL), f32)
    return {"x": x, "p": p, "positions": positions, "w_in": w_in, "attn_norm_g": attn_norm_g,
            "ssd_conv_w": ssd_conv_w, "ssd_conv_b": ssd_conv_b, "ssd_dt_bias": ssd_dt_bias,
            "ssd_a_log": ssd_a_log, "ssd_d": ssd_d, "ssd_norm_g": ssd_norm_g, "w_out": w_out,
            "ln1_g": ln1_g, "ln1_b": ln1_b, "w_up": w_up, "ffn_conv_w": ffn_conv_w,
            "ffn_conv_b": ffn_conv_b, "w_down": w_down, "w_pe_gate": w_pe_gate,
            "w_pe_proj": w_pe_proj, "ln2_g": ln2_g, "ln2_b": ln2_b}


def reference(x, p, positions, w_in, attn_norm_g, ssd_conv_w, ssd_conv_b, ssd_dt_bias, ssd_a_log,
              ssd_d, ssd_norm_g, w_out, ln1_g, ln1_b, w_up, ffn_conv_w, ffn_conv_b, w_down,
              w_pe_gate, w_pe_proj, ln2_g, ln2_b):
    B, S, _ = x.shape
    A = ATTN_WIDTH
    splits = [A, 2 * A, 3 * A, 3 * A + SSD_WIDTH, 3 * A + SSD_WIDTH + SSD_CONV_DIM]
    h = x
    for i in range(DEPTH):
        proj = h @ w_in[i]
        q, k, v, z, xbc, dt_raw = jnp.split(proj, splits, axis=-1)
        q = partial_rope(q.reshape(B, S, ATTN_HEADS, ATTN_HEAD_DIM), positions)
        k = partial_rope(k.reshape(B, S, ATTN_HEADS, ATTN_HEAD_DIM), positions)
        v = v.reshape(B, S, ATTN_HEADS, ATTN_HEAD_DIM)
        attn_out = rms_norm(moba_attention(q, k, v), attn_norm_g[i])
        ssd_out = ssd_mixer(z, xbc, dt_raw, ssd_conv_w[i], ssd_conv_b[i], ssd_dt_bias[i],
                            ssd_a_log[i], ssd_d[i], ssd_norm_g[i])
        mix = jnp.concatenate([attn_out, ssd_out], axis=-1) @ w_out[i]
        h = layer_norm(DEEPNORM_ALPHA * h + mix, ln1_g[i], ln1_b[i])
        ffn = conv_ffn(h, w_up[i], ffn_conv_w[i], ffn_conv_b[i], w_down[i])
        ple = (p[i] @ w_pe_proj[i]) * jax.nn.sigmoid(h @ w_pe_gate[i])
        h = layer_norm(DEEPNORM_ALPHA * h + ffn + ple, ln2_g[i], ln2_b[i])
    return h
```

```cpp
#include <hip/hip_runtime.h>
#include <cstdio>
#include <cstdint>
#include <cmath>
#include <utility>
namespace pg8 {
#define PG8_LAS __attribute__((address_space(3)))
typedef unsigned short bf16_t;
typedef short bf16x8 __attribute__((ext_vector_type(8)));
typedef float f32x4 __attribute__((ext_vector_type(4)));
typedef unsigned u32x4 __attribute__((ext_vector_type(4)));
constexpr int BM = 256, BK = 64, HALF = 128, HTB = HALF * BK * 2  , STAGE_BYTES = 8 * HTB, NXCD = 8, WGM = 8;

__host__ __device__ __forceinline__ int lds_byte(int r, int c) { const int st = (r >> 4) * 2 + (c >> 5), rr = r & 15, cc = c & 31, ob = rr * 64 + cc * 2; return st * 1024 + (ob ^ (((ob >> 9) & 1) << 5)); }
__host__ __device__ __forceinline__ void stage_rc(int b, int& R, int& C) { const int st = b / 1024, sb = b % 1024, swz = sb ^ (((sb >> 9) & 1) << 5); R = (st >> 1) * 16 + swz / 64; C = (st & 1) * 32 + (swz % 64) / 2; }
__host__ __device__ __forceinline__ int perm32(int rho) { const int n = rho >> 4, i = rho & 15; return 8 * (i >> 2) + 4 * n + (i & 3); }

struct Unit { int pm, pn; };
struct Gemm { const bf16_t* A; const bf16_t* Bt; int M, N, K; };

struct StaticOrder {
    int nM, nN, nwg, G, c;
    __host__ __device__ void init(int M, int N, int G_, int c_) { nM = M / BM; nN = N / BM; nwg = nM * nN; G = G_; c = c_; }
    __host__ __device__ bool next(int i, Unit& u) const {
        const long L = (long)i * G + c; if (L >= nwg) return false;
        int wgid = (int)L; { const int q = nwg / NXCD, r = nwg % NXCD, xcd = wgid % NXCD, off = wgid / NXCD; wgid = (xcd < r ? xcd * (q + 1) : r * (q + 1) + (xcd - r) * q) + off; }
        const int nig = WGM * nN, gid = wgid / nig, fm = gid * WGM, gsz = (nM - fm) < WGM ? (nM - fm) : WGM;
        u.pm = fm + ((wgid % nig) % gsz); u.pn = (wgid % nig) / gsz; return true;
    }
    __device__ __forceinline__ void a_ready(const Unit&) const {}
    __device__ __forceinline__ void done(const Unit&) const {}
};

__device__ __forceinline__ unsigned cvt_pk_bf16(float lo, float hi) { unsigned r; asm volatile("v_cvt_pk_bf16_f32 %0, %1, %2" : "=v"(r) : "v"(lo), "v"(hi)); return r; }
typedef float f32x2 __attribute__((ext_vector_type(2)));
__device__ __forceinline__ f32x2 gelu_pk(f32x2 v) {
    const f32x2 av = __builtin_elementwise_abs(v), d = av * 0.2316418882f + 1.0f;
    f32x2 t; t.x = __builtin_amdgcn_rcpf(d.x); t.y = __builtin_amdgcn_rcpf(d.y);
    f32x2 q = t * 0.5307027145f + (-0.7265760135f); q = q * t + 0.7107068705f; q = q * t + (-0.142248368f); q = q * t + 0.127414796f; q = q * t;
    const f32x2 s = (v * v) * (-0.72134752044f);
    f32x2 e; e.x = __builtin_amdgcn_exp2f(s.x); e.y = __builtin_amdgcn_exp2f(s.y);
    const f32x2 m = v * (q * e), r = v - m;
    f32x2 o; o.x = v.x < 0.f ? m.x : r.x; o.y = v.y < 0.f ? m.y : r.y; return o;
}

template <int ACT  > struct EpiBf16 {
    static constexpr bool PERM = true, AFTER_DRAIN = false; static_assert(ACT == 0 || ACT == 1, "EpiBf16: ACT is 0 (none) or 1 (gelu_pk)");
    bf16_t* O; int ldc; const float* bias; int split_cols; size_t split_stride; float scale0;
    __device__ __forceinline__ void operator()(const f32x4 (&acc)[2][2][4][2], const Unit& u, int wr, int wc, int fr, int fq) const {
        const int row0 = u.pm * BM + wr * 64 + fr; int colt = u.pn * BM; bf16_t* base = O;
        float sc = 1.f; if (split_cols) { const int t = colt / split_cols; base += (size_t)t * split_stride; colt -= t * split_cols; if (t == 0) sc = scale0; }
        const int col0 = colt + wc * 32 + 8 * fq, bcol0 = u.pn * BM + wc * 32 + 8 * fq;
        f32x4 bv[2][2];
#pragma unroll
        for (int bj = 0; bj < 2; ++bj)
#pragma unroll
            for (int n = 0; n < 2; ++n) bv[bj][n] = bias ? *(const f32x4*)(bias + bcol0 + bj * HALF + 4 * n) : (f32x4){0.f, 0.f, 0.f, 0.f};
#pragma unroll
        for (int ai = 0; ai < 2; ++ai)
#pragma unroll
            for (int m = 0; m < 4; ++m) { bf16_t* rowp = base + (size_t)(row0 + ai * HALF + m * 16) * ldc + col0;
#pragma unroll
                for (int bj = 0; bj < 2; ++bj) { f32x4 v0 = acc[ai][bj][m][0] + bv[bj][0], v1 = acc[ai][bj][m][1] + bv[bj][1];
                    if (ACT == 1) { f32x2 a = gelu_pk((f32x2){v0[0], v0[1]}), b = gelu_pk((f32x2){v0[2], v0[3]}), c = gelu_pk((f32x2){v1[0], v1[1]}), d = gelu_pk((f32x2){v1[2], v1[3]});
                        v0 = (f32x4){a.x, a.y, b.x, b.y}; v1 = (f32x4){c.x, c.y, d.x, d.y}; }
                    v0 = v0 * sc; v1 = v1 * sc; u32x4 w; w.x = cvt_pk_bf16(v0[0], v0[1]); w.y = cvt_pk_bf16(v0[2], v0[3]); w.z = cvt_pk_bf16(v1[0], v1[1]); w.w = cvt_pk_bf16(v1[2], v1[3]);
                    *(u32x4*)(rowp + bj * HALF) = w; } }
    }
};

struct PanelStats {
    unsigned* xbuf;
    unsigned* cnt;
    unsigned* tmo;
    int ntn; float eps;
    unsigned code;
    __device__ __forceinline__ bool run(const f32x4 (&v)[2][2][4][2], const Unit& u, int wr, int wc, int fr, int fq, PG8_LAS unsigned char* lds, int wid, int lane) const {
        typedef float f32x2v __attribute__((ext_vector_type(2)));
        PG8_LAS f32x2v* P = (PG8_LAS f32x2v*)lds;
        PG8_LAS f32x2v* S = (PG8_LAS f32x2v*)(lds + 8192);
        PG8_LAS unsigned* flag = (PG8_LAS unsigned*)(lds + 8192 + 2048);
#pragma unroll
        for (int ai = 0; ai < 2; ++ai)
#pragma unroll
            for (int m = 0; m < 4; ++m) {
                float s = 0.f;
#pragma unroll
                for (int bj = 0; bj < 2; ++bj)
#pragma unroll
                    for (int n = 0; n < 2; ++n) { const f32x4 x = v[ai][bj][m][n]; s += (x[0] + x[1]) + (x[2] + x[3]); }
                s += __shfl_xor(s, 16); s += __shfl_xor(s, 32);
                const float mw = s * (1.0f / 64.0f); float q = 0.f;
#pragma unroll
                for (int bj = 0; bj < 2; ++bj)
#pragma unroll
                    for (int n = 0; n < 2; ++n) { const f32x4 d = v[ai][bj][m][n] - mw; q += (d[0] * d[0] + d[1] * d[1]) + (d[2] * d[2] + d[3] * d[3]); }
                q += __shfl_xor(q, 16); q += __shfl_xor(q, 32);
                if (fq == 0) P[(ai * HALF + wr * 64 + m * 16 + fr) * 4 + wc] = (f32x2v){mw, q};
            }
        asm volatile("s_waitcnt lgkmcnt(0)" ::: "memory"); __builtin_amdgcn_s_barrier(); asm volatile("" ::: "memory");
#if defined(BROKEN_EXCHANGE_NO_WAIT)
#warning BROKEN CONTROL BUILD: the row-statistics exchange does not wait; results are wrong by design
        if (blockIdx.x >= 64) { const long long t0_ = clock64(); while (clock64() - t0_ < 60000) __builtin_amdgcn_s_sleep(8); }
#endif
        const int row = wid * 32 + (lane & 31);
        if (lane < 32) {
            const f32x2v a = P[row * 4 + 0], b = P[row * 4 + 1], c = P[row * 4 + 2], d = P[row * 4 + 3];
            const float mt = (a.x + b.x + c.x + d.x) * 0.25f;
            const float da = a.x - mt, db = b.x - mt, dc = c.x - mt, dd = d.x - mt;
            const float m2 = (a.y + b.y) + (c.y + d.y) + 64.0f * ((da * da + db * db) + (dc * dc + dd * dd));
            unsigned long long* slot = (unsigned long long*)xbuf + ((size_t)(u.pm * BM + row) * 4 + u.pn);
            __hip_atomic_store(slot, ((unsigned long long)__float_as_uint(m2) << 32) | __float_as_uint(mt), __ATOMIC_RELAXED, __HIP_MEMORY_SCOPE_AGENT);
        }
        asm volatile("s_waitcnt vmcnt(0)" ::: "memory");
        if (lane == 0) __hip_atomic_fetch_add(cnt + 64 * u.pm, 1u, __ATOMIC_RELAXED, __HIP_MEMORY_SCOPE_AGENT);
        if (wid == 0) {
            bool dead = false; const unsigned long long t0 = __builtin_amdgcn_s_memrealtime(); const unsigned want = 8u * (unsigned)ntn;
            for (;;) {
#if defined(BROKEN_EXCHANGE_NO_WAIT)
                break;
#endif
                if ((unsigned)__builtin_amdgcn_readfirstlane(__hip_atomic_load(cnt + 64 * u.pm, __ATOMIC_RELAXED, __HIP_MEMORY_SCOPE_AGENT)) >= want) break;
                if (__builtin_amdgcn_s_memrealtime() - t0 > 2000000ull) {
                    if (lane == 0) { unsigned expect = 0u; __hip_atomic_compare_exchange_strong(tmo + 1, &expect, code | (unsigned)(u.pm & 0xff), __ATOMIC_RELAXED, __ATOMIC_RELAXED, __HIP_MEMORY_SCOPE_AGENT);
                                     __hip_atomic_store(tmo, 1u, __ATOMIC_RELAXED, __HIP_MEMORY_SCOPE_AGENT); }
                    dead = true; break; }
                __builtin_amdgcn_s_sleep(2);
            }
            __builtin_amdgcn_fence(__ATOMIC_ACQUIRE, "agent");
            if (lane == 0) flag[0] = dead ? 1u : 0u;
        }
        asm volatile("s_waitcnt vmcnt(0) lgkmcnt(0)" ::: "memory"); __builtin_amdgcn_s_barrier(); asm volatile("" ::: "memory");
        const bool bad = flag[0] != 0u;
        if (lane < 32) {
            const unsigned long long* slot = (const unsigned long long*)xbuf + (size_t)(u.pm * BM + row) * 4; float mt[4], m2[4]; float ms = 0.f;
#pragma unroll
            for (int t = 0; t < 4; ++t) { if (t < ntn) { const unsigned long long w = __hip_atomic_load(slot + t, __ATOMIC_RELAXED, __HIP_MEMORY_SCOPE_AGENT); mt[t] = __uint_as_float((unsigned)w); m2[t] = __uint_as_float((unsigned)(w >> 32)); } else { mt[t] = 0.f; m2[t] = 0.f; } ms += mt[t]; }
            const float mean = ms / (float)ntn; float q = 0.f;
#pragma unroll
            for (int t = 0; t < 4; ++t) if (t < ntn) { const float dm = mt[t] - mean; q += m2[t] + 256.0f * dm * dm; }
            S[row] = (f32x2v){mean, 1.0f / sqrtf(q / (256.0f * (float)ntn) + eps)};
        }
        asm volatile("s_waitcnt lgkmcnt(0)" ::: "memory"); __builtin_amdgcn_s_barrier(); asm volatile("" ::: "memory");
        return bad;
    }
};
struct EpiLnRes {
    static constexpr bool PERM = false, AFTER_DRAIN = true;
    const float* base; float* out; int ldc; const float* bias; PanelStats st; unsigned poison;
    __device__ __forceinline__ void fused(f32x4 (&acc)[2][2][4][2], const Unit& u, int wr, int wc, int fr, int fq, PG8_LAS unsigned char* lds, int wid, int lane) const {
        typedef float f32x2v __attribute__((ext_vector_type(2)));
        const PG8_LAS f32x2v* S = (const PG8_LAS f32x2v*)(lds + 8192);
        const int col0 = u.pn * BM + wc * 32 + 4 * fq;
#pragma unroll
        for (int bj = 0; bj < 2; ++bj)
#pragma unroll
            for (int n = 0; n < 2; ++n) { const f32x4 bv = bias ? *(const f32x4*)(bias + col0 + bj * HALF + n * 16) : (f32x4){0.f, 0.f, 0.f, 0.f};
#pragma unroll
                for (int ai = 0; ai < 2; ++ai)
#pragma unroll
                    for (int m = 0; m < 4; ++m) acc[ai][bj][m][n] += bv; }
        f32x4 pre[4][2][2];
#pragma unroll
        for (int m = 0; m < 4; ++m) { const size_t off = (size_t)(u.pm * BM + wr * 64 + m * 16 + fr) * ldc + col0;
#pragma unroll
            for (int bj = 0; bj < 2; ++bj)
#pragma unroll
                for (int n = 0; n < 2; ++n) pre[m][bj][n] = *(const f32x4*)(base + off + bj * HALF + n * 16); }
        const bool bad = st.run(acc, u, wr, wc, fr, fq, lds, wid, lane) || poison != 0u;
        const float qnan = __builtin_nanf("");
#pragma unroll
        for (int ai = 0; ai < 2; ++ai)
#pragma unroll
            for (int m = 0; m < 4; ++m) { const int r = ai * HALF + wr * 64 + m * 16 + fr; const f32x2v sr = S[r]; const size_t off = (size_t)(u.pm * BM + r) * ldc + col0;
#pragma unroll
                for (int bj = 0; bj < 2; ++bj)
#pragma unroll
                    for (int n = 0; n < 2; ++n) { const f32x4 bs = ai == 0 ? pre[m][bj][n] : *(const f32x4*)(base + off + bj * HALF + n * 16); f32x4 o = bs + (acc[ai][bj][m][n] - sr.x) * sr.y;
                        if (bad) o = (f32x4){qnan, qnan, qnan, qnan}; *(f32x4*)(out + off + bj * HALF + n * 16) = o; }
                if (m & 1) asm volatile("" ::: "memory"); }
    }
};
struct EpiLnResLn {
    static constexpr bool PERM = false, AFTER_DRAIN = true;
    const float* base; float* out; bf16_t* xn; int ldc; const float* bias; PanelStats st1, st2; unsigned poison;
    __device__ __forceinline__ void fused(f32x4 (&acc)[2][2][4][2], const Unit& u, int wr, int wc, int fr, int fq, PG8_LAS unsigned char* lds, int wid, int lane) const {
        typedef float f32x2v __attribute__((ext_vector_type(2))); typedef unsigned u32x2v __attribute__((ext_vector_type(2)));
        const PG8_LAS f32x2v* S = (const PG8_LAS f32x2v*)(lds + 8192);
        const int col0 = u.pn * BM + wc * 32 + 4 * fq;
#pragma unroll
        for (int bj = 0; bj < 2; ++bj)
#pragma unroll
            for (int n = 0; n < 2; ++n) { const f32x4 bv = bias ? *(const f32x4*)(bias + col0 + bj * HALF + n * 16) : (f32x4){0.f, 0.f, 0.f, 0.f};
#pragma unroll
                for (int ai = 0; ai < 2; ++ai)
#pragma unroll
                    for (int m = 0; m < 4; ++m) acc[ai][bj][m][n] += bv; }
        bool bad = st1.run(acc, u, wr, wc, fr, fq, lds, wid, lane) || poison != 0u;
        const float qnan = __builtin_nanf("");
#pragma unroll
        for (int ai = 0; ai < 2; ++ai)
#pragma unroll
            for (int m = 0; m < 4; ++m) { const int r = ai * HALF + wr * 64 + m * 16 + fr; const f32x2v sr = S[r]; const size_t off = (size_t)(u.pm * BM + r) * ldc + col0;
#pragma unroll
                for (int bj = 0; bj < 2; ++bj)
#pragma unroll
                    for (int n = 0; n < 2; ++n) { const f32x4 bs = *(const f32x4*)(base + off + bj * HALF + n * 16); acc[ai][bj][m][n] = bs + (acc[ai][bj][m][n] - sr.x) * sr.y; }
                asm volatile("" : "+v"(acc[ai][0][m][0]), "+v"(acc[ai][0][m][1]), "+v"(acc[ai][1][m][0]), "+v"(acc[ai][1][m][1]));
                if (m & 1) asm volatile("" ::: "memory"); }
        const bool bad1 = bad;
        bad = st2.run(acc, u, wr, wc, fr, fq, lds, wid, lane) || bad;
#pragma unroll
        for (int ai = 0; ai < 2; ++ai)
#pragma unroll
            for (int m = 0; m < 4; ++m) { const int r = ai * HALF + wr * 64 + m * 16 + fr; const f32x2v sr = S[r]; const size_t off = (size_t)(u.pm * BM + r) * ldc + col0;
#pragma unroll
                for (int bj = 0; bj < 2; ++bj)
#pragma unroll
                    for (int n = 0; n < 2; ++n) { const f32x4 x1 = acc[ai][bj][m][n]; *(f32x4*)(out + off + bj * HALF + n * 16) = bad1 ? (f32x4){qnan, qnan, qnan, qnan} : x1;
                        const f32x4 o = (x1 - sr.x) * sr.y; u32x2v w; w.x = cvt_pk_bf16(o[0], o[1]); w.y = cvt_pk_bf16(o[2], o[3]);
                        if (bad) { w.x = 0x7fc07fc0u; w.y = 0x7fc07fc0u; } *(u32x2v*)(xn + off + bj * HALF + n * 16) = w; }
                asm volatile("" ::: "memory"); }
    }
};

template <class Epi, class Sched, bool ALIGN_EPI = false, bool SP2 = false>
__device__ __forceinline__ void gemm_phase(PG8_LAS unsigned char* lds, const Gemm g, const Sched& S, const Epi& E) {
    const int tid = threadIdx.x, wid = __builtin_amdgcn_readfirstlane(tid >> 6), lane = tid & 63, wr = wid >> 2, wc = wid & 3, fr = lane & 15, fq = lane >> 4;
    const int K = g.K, nt = K / BK;
    unsigned voffA[2], voffB[2];
#pragma unroll
    for (int i = 0; i < 2; ++i) { int R, C; stage_rc(tid * 16 + i * 8192, R, C); const int Rb = Epi::PERM ? ((R & ~31) + perm32(R & 31)) : R;
        voffA[i] = (unsigned)(R * K + C) * 2u; voffB[i] = (unsigned)(Rb * K + C) * 2u; }
    const size_t kstep = (size_t)(BK * 2);
    const size_t hstep = (size_t)HALF * K * 2;
    const size_t tstep = 2 * hstep;
    const unsigned ldsw = (unsigned)wid * 1024u;
    const int aoff = lds_byte(wr * 64 + fr, fq * 8), boff = lds_byte(wc * 32 + fr, fq * 8);
#define PG8_SA(b, h) (((b) * 2 + (h)) * HTB)
#define PG8_SB(b, h) ((4 + (b) * 2 + (h)) * HTB)
#define PG8_STAGE(bufoff, gbase, voff) do { _Pragma("unroll") for (int _i = 0; _i < 2; ++_i) \
        __builtin_amdgcn_global_load_lds((const unsigned*)((const char*)(gbase) + (voff)[_i]), (PG8_LAS unsigned*)(lds + (bufoff) + ldsw + _i * 8192), 16, 0, 0); } while (0)
#define PG8_LDA(dst, b, h) do { _Pragma("unroll") for (int m = 0; m < 4; ++m) _Pragma("unroll") for (int k = 0; k < 2; ++k) dst[m][k] = *(const PG8_LAS bf16x8*)(lds + PG8_SA(b, h) + aoff + m * 2048 + k * 1024); } while (0)
#define PG8_LDB(dst, b, h) do { _Pragma("unroll") for (int n = 0; n < 2; ++n) _Pragma("unroll") for (int k = 0; k < 2; ++k) dst[n][k] = *(const PG8_LAS bf16x8*)(lds + PG8_SB(b, h) + boff + n * 2048 + k * 1024); } while (0)
#define PG8_MMA(ai, bj, At, Bt) do { __builtin_amdgcn_s_setprio(1); _Pragma("unroll") for (int m = 0; m < 4; ++m) _Pragma("unroll") for (int n = 0; n < 2; ++n) _Pragma("unroll") for (int k = 0; k < 2; ++k) \
        acc[ai][bj][m][n] = __builtin_amdgcn_mfma_f32_16x16x32_bf16(Bt[n][k], At[m][k], acc[ai][bj][m][n], 0, 0, 0); __builtin_amdgcn_s_setprio(0); } while (0)
#define PG8_WAIT_V(n) asm volatile("s_waitcnt vmcnt(" #n ")" ::: "memory")
#define PG8_WAIT_L(n) asm volatile("s_waitcnt lgkmcnt(" #n ")" ::: "memory")
#define PG8_BAR __builtin_amdgcn_s_barrier()
#define PG8_SCHED __builtin_amdgcn_sched_barrier(0)
    Unit cur, nxt; int ui = 0;
    if (!S.next(0, cur)) return;
    f32x4 acc[2][2][4][2];
#pragma unroll
    for (int a = 0; a < 2; ++a)
#pragma unroll
        for (int b = 0; b < 2; ++b)
#pragma unroll
            for (int m = 0; m < 4; ++m)
#pragma unroll
                for (int n = 0; n < 2; ++n) acc[a][b][m][n] = (f32x4){0.f, 0.f, 0.f, 0.f};
    bf16x8 At[4][2], B0[2][2], B1[2][2];
    const char* cA = (const char*)g.A + (size_t)cur.pm * tstep; const char* cB = (const char*)g.Bt + (size_t)cur.pn * tstep;
    S.a_ready(cur);
    if constexpr (SP2) {
        PG8_STAGE(PG8_SB(0, 0), cB, voffB); PG8_STAGE(PG8_SB(0, 1), cB + hstep, voffB); PG8_STAGE(PG8_SA(0, 0), cA, voffA); PG8_STAGE(PG8_SA(0, 1), cA + hstep, voffA);
        if (wr == 1) PG8_BAR;
        PG8_WAIT_V(2); PG8_BAR;
        PG8_STAGE(PG8_SB(1, 0), cB + kstep, voffB); PG8_STAGE(PG8_SA(1, 0), cA + kstep, voffA); PG8_STAGE(PG8_SB(1, 1), cB + hstep + kstep, voffB);
        PG8_WAIT_V(6); PG8_BAR;
    } else {
        PG8_STAGE(PG8_SB(0, 0), cB, voffB); PG8_STAGE(PG8_SA(0, 0), cA, voffA); PG8_STAGE(PG8_SB(0, 1), cB + hstep, voffB); PG8_STAGE(PG8_SA(0, 1), cA + hstep, voffA);
        if (wr == 1) PG8_BAR;
        PG8_WAIT_V(4); PG8_BAR;
        PG8_STAGE(PG8_SB(1, 0), cB + kstep, voffB); PG8_STAGE(PG8_SA(1, 0), cA + kstep, voffA); PG8_STAGE(PG8_SB(1, 1), cB + hstep + kstep, voffB);
        PG8_WAIT_V(6); PG8_BAR;
    }
    for (;;) {
        const bool has_next = S.next(ui + 1, nxt);
        const char* nA = has_next ? (const char*)g.A + (size_t)nxt.pm * tstep : cA; const char* nB = has_next ? (const char*)g.Bt + (size_t)nxt.pn * tstep : cB;
        for (int t = 0; t < nt; t += 2) {
            const bool last = (t == nt - 2);
            const char* a1 = cA + (size_t)(t + 1) * kstep;
            const char* a2 = last ? nA : cA + (size_t)(t + 2) * kstep; const char* b2 = last ? nB : cB + (size_t)(t + 2) * kstep;
            const char* a3 = a2 + kstep; const char* b3 = b2 + kstep;
            if (last && has_next) S.a_ready(nxt);
            if constexpr (SP2) {
            PG8_LDB(B0, 0, 0); PG8_LDB(B1, 0, 1); PG8_SCHED; PG8_LDA(At, 0, 0); PG8_STAGE(PG8_SA(1, 1), a1 + hstep, voffA);
            PG8_WAIT_V(8); PG8_WAIT_L(0); PG8_BAR; PG8_MMA(0, 0, At, B0); PG8_MMA(0, 1, At, B1); PG8_BAR; PG8_SCHED;
            PG8_LDA(At, 0, 1); PG8_STAGE(PG8_SB(0, 0), b2, voffB); PG8_STAGE(PG8_SB(0, 1), b2 + hstep, voffB); PG8_STAGE(PG8_SA(0, 0), a2, voffA);
            PG8_WAIT_V(8); PG8_WAIT_L(0); PG8_BAR; PG8_MMA(1, 0, At, B0); PG8_MMA(1, 1, At, B1); PG8_BAR; PG8_SCHED;
            PG8_LDB(B0, 1, 0); PG8_LDB(B1, 1, 1); PG8_SCHED; PG8_LDA(At, 1, 0); PG8_STAGE(PG8_SA(0, 1), a2 + hstep, voffA);
            PG8_WAIT_V(8); PG8_WAIT_L(0); PG8_BAR; PG8_MMA(0, 0, At, B0); PG8_MMA(0, 1, At, B1); PG8_BAR; PG8_SCHED;
            PG8_LDA(At, 1, 1); PG8_STAGE(PG8_SB(1, 0), b3, voffB); PG8_STAGE(PG8_SB(1, 1), b3 + hstep, voffB); PG8_STAGE(PG8_SA(1, 0), a3, voffA);
            PG8_WAIT_V(8); PG8_WAIT_L(0); PG8_BAR; PG8_MMA(1, 0, At, B0); PG8_MMA(1, 1, At, B1); PG8_BAR; PG8_SCHED;
            } else {
            PG8_LDB(B0, 0, 0); PG8_SCHED; PG8_LDA(At, 0, 0); PG8_STAGE(PG8_SA(1, 1), a1 + hstep, voffA);
            PG8_WAIT_L(8); PG8_BAR; PG8_WAIT_L(0); PG8_MMA(0, 0, At, B0); PG8_BAR; PG8_SCHED;
            PG8_LDB(B1, 0, 1); PG8_STAGE(PG8_SB(0, 0), b2, voffB);
            PG8_BAR; PG8_WAIT_L(0); PG8_MMA(0, 1, At, B1); PG8_BAR;
            PG8_LDA(At, 0, 1); PG8_STAGE(PG8_SA(0, 0), a2, voffA);
            PG8_BAR; PG8_WAIT_L(0); PG8_MMA(1, 0, At, B0); PG8_BAR; PG8_SCHED;
            PG8_STAGE(PG8_SB(0, 1), b2 + hstep, voffB);
            PG8_WAIT_V(6); PG8_BAR; PG8_MMA(1, 1, At, B1); PG8_BAR;
            PG8_LDB(B0, 1, 0); PG8_SCHED; PG8_LDA(At, 1, 0); PG8_STAGE(PG8_SA(0, 1), a2 + hstep, voffA);
            PG8_WAIT_L(8); PG8_BAR; PG8_WAIT_L(0); PG8_MMA(0, 0, At, B0); PG8_BAR; PG8_SCHED;
            PG8_LDB(B1, 1, 1); PG8_STAGE(PG8_SB(1, 0), b3, voffB);
            PG8_BAR; PG8_WAIT_L(0); PG8_MMA(0, 1, At, B1); PG8_BAR;
            PG8_LDA(At, 1, 1); PG8_STAGE(PG8_SA(1, 0), a3, voffA);
            PG8_BAR; PG8_WAIT_L(0); PG8_MMA(1, 0, At, B0); PG8_BAR; PG8_SCHED;
            PG8_STAGE(PG8_SB(1, 1), b3 + hstep, voffB);
            PG8_WAIT_V(6); PG8_BAR; PG8_MMA(1, 1, At, B1); PG8_BAR;
            }
        }
        if constexpr (ALIGN_EPI) { if (wr == 0) PG8_BAR; }
        if constexpr (!Epi::AFTER_DRAIN) { E(acc, cur, wr, wc, fr, fq); S.done(cur); }
        if (!has_next) break;
#pragma unroll
        for (int a = 0; a < 2; ++a)
#pragma unroll
            for (int b = 0; b < 2; ++b)
#pragma unroll
                for (int m = 0; m < 4; ++m)
#pragma unroll
                    for (int n = 0; n < 2; ++n) acc[a][b][m][n] = (f32x4){0.f, 0.f, 0.f, 0.f};
        cur = nxt; cA = nA; cB = nB; ++ui;
        if constexpr (ALIGN_EPI) { if (wr == 1) PG8_BAR; }
    }
    PG8_WAIT_V(0);
    if constexpr (!ALIGN_EPI) { if (wr == 0) PG8_BAR; }
    PG8_BAR;
    if constexpr (Epi::AFTER_DRAIN) { E.fused(acc, cur, wr, wc, fr, fq, lds, wid, lane); S.done(cur); }
#undef PG8_SA
#undef PG8_SB
#undef PG8_STAGE
#undef PG8_LDA
#undef PG8_LDB
#undef PG8_MMA
#undef PG8_WAIT_V
#undef PG8_WAIT_L
#undef PG8_BAR
#undef PG8_SCHED
}
}
#define GAS __attribute__((address_space(1)))
#define LAS __attribute__((address_space(3)))
typedef unsigned short bf16;
typedef unsigned v4u __attribute__((ext_vector_type(4)));
typedef float f32x4 __attribute__((ext_vector_type(4)));
typedef short bf16x8 __attribute__((ext_vector_type(8)));
typedef GAS unsigned gu32;
typedef GAS unsigned long long gu64;
#define RLX_AGENT __ATOMIC_RELAXED, __HIP_MEMORY_SCOPE_AGENT
#define LDS_WAIT() asm volatile("s_waitcnt lgkmcnt(0)" ::: "memory")
#define VM_WAIT() asm volatile("s_waitcnt vmcnt(0)" ::: "memory")
__device__ __forceinline__ unsigned long long rt() { return __builtin_amdgcn_s_memrealtime(); }
__device__ __forceinline__ unsigned f2bf(float f) { unsigned u = __builtin_bit_cast(unsigned, f); return (u + 0x7fffu + ((u >> 16) & 1u)) >> 16; }
__device__ __forceinline__ unsigned pk2(float lo, float hi) { return f2bf(lo) | (f2bf(hi) << 16); }

#define XB_TMO      128
#define XB_XCNT(j)  (256  + 64 * (j))
#define XB_XSUB(j)  (1280 + 64 * (j))
#define XB_XGEN(j)  (2304 + 64 * (j))
#define XB_TOP      3328
#define XB_TOPGEN   3392
#define XCD_BAR_WORDS 3456
#define XB_SPIN_CAP (1u << 18)

__device__ __forceinline__ unsigned xb_ld(unsigned* p)              { return __hip_atomic_load(p, __ATOMIC_RELAXED, __HIP_MEMORY_SCOPE_AGENT); }
__device__ __forceinline__ unsigned xb_add(unsigned* p, unsigned v) { return __hip_atomic_fetch_add(p, v, __ATOMIC_RELAXED, __HIP_MEMORY_SCOPE_AGENT); }
__device__ __forceinline__ unsigned xb_xcc_id() { return (unsigned)__builtin_amdgcn_s_getreg((3 << 11) | 20) & 0xFu; }
#define XB_SPIN(cond, bar) do { unsigned _sp = 0; while (cond) { __builtin_amdgcn_s_sleep(1); \
    if ((++_sp & 255u) == 0u) { if (xb_ld(&(bar)[XB_TMO])) break; if (_sp > XB_SPIN_CAP) { atomicAdd(&(bar)[XB_TMO], 1u); break; } } } } while (0)

struct XcdBarrier {
    unsigned* bar; unsigned x;
    volatile LAS unsigned* st;
};

__device__ __forceinline__ XcdBarrier xcd_barrier_post(unsigned* bar, volatile LAS unsigned* st) {
    XcdBarrier b; b.bar = bar; b.x = xb_xcc_id(); b.st = st;
    if (threadIdx.x == 0) (void)xb_add(&bar[XB_XCNT(b.x)], 1u);
    return b;
}
__device__ __forceinline__ void xcd_barrier_complete(unsigned* bar, unsigned x, unsigned& nloc, unsigned& nx) {
    const unsigned G = gridDim.x * gridDim.y * gridDim.z;
    unsigned sum, cnt, mine, sp = 0u;
    for (;;) {
        sum = 0u; cnt = 0u; mine = 0u;
#pragma unroll
        for (unsigned j = 0; j < 16; ++j) { const unsigned c = xb_ld(&bar[XB_XCNT(j)]); sum += c; cnt += (c > 0u) ? 1u : 0u; mine = (j == x) ? c : mine; }
        if (sum == G) break;
        __builtin_amdgcn_s_sleep(1);
        if ((++sp & 255u) == 0u) { if (xb_ld(&bar[XB_TMO])) break; if (sp > XB_SPIN_CAP) { atomicAdd(&bar[XB_TMO], 1u); break; } }
    }
    nloc = mine > 0u ? mine : 1u; nx = cnt > 0u ? cnt : 1u;
}

__device__ __forceinline__ void xcd_barrier(const XcdBarrier& b) {
    asm volatile("s_waitcnt vmcnt(0)" ::: "memory");
    __syncthreads();
    if (threadIdx.x == 0) {
        unsigned* bar = b.bar;
        __builtin_amdgcn_s_waitcnt(0);
        unsigned nloc = b.st[0], nx = b.st[1];
        if (nloc == 0u) { xcd_barrier_complete(bar, b.x, nloc, nx); b.st[0] = nloc; b.st[1] = nx; }
        const unsigned old = xb_add(&bar[XB_XSUB(b.x)], 1u);
        const unsigned gen = old / nloc;
        if (old + 1u == (gen + 1u) * nloc) {
            __builtin_amdgcn_fence(__ATOMIC_RELEASE, "agent");
            asm volatile("s_waitcnt vmcnt(0)" ::: "memory");
            const unsigned og = xb_add(&bar[XB_TOP], 1u);
            const unsigned tg = og / nx;
            if (og + 1u == (tg + 1u) * nx) xb_add(&bar[XB_TOPGEN], 1u);
            else XB_SPIN(xb_ld(&bar[XB_TOPGEN]) == tg, bar);
            __builtin_amdgcn_fence(__ATOMIC_ACQUIRE, "agent");
            xb_add(&bar[XB_XGEN(b.x)], 1u);
            asm volatile("s_waitcnt vmcnt(0)" ::: "memory");
        } else {
            XB_SPIN(xb_ld(&bar[XB_XGEN(b.x)]) == gen, bar);
            __builtin_amdgcn_fence(__ATOMIC_ACQUIRE, "agent");
            asm volatile("s_waitcnt vmcnt(0)" ::: "memory");
        }
    }
    __syncthreads();
}
constexpr int S_ = 8192, DM = 2048, DEPTH = 4;
constexpr int NIN = 5648, NINP = 5888;
constexpr int C_Q = 0, C_K = 1024, C_V = 2048, C_Z = 3072, C_X = 4096, C_DT = 5632;
constexpr int FF = 5632, FF2 = 11264, PE = 256;
constexpr float ALPHA = 1.681792830507429f;
constexpr float LN_EPS = 1e-5f, RMS_EPS = 1e-6f;
constexpr int NWAVES = 8, NTHR = 512;
constexpr int NPH = 12;

constexpr size_t al4k(size_t x) { return (x + 4095) & ~(size_t)4095; }
constexpr size_t CTL_BYTES = 1u << 20;
constexpr size_t SZ_WIN = (size_t)NINP * DM * 2, SZ_WOUT = (size_t)DM * DM * 2, SZ_WUP = (size_t)FF2 * DM * 2, SZ_WDN = (size_t)DM * FF * 2, SZ_WPG = (size_t)DM * DM * 2, SZ_WPP = (size_t)DM * PE * 2;
constexpr size_t OFF_WOUT = SZ_WIN, OFF_WUP = OFF_WOUT + SZ_WOUT, OFF_WDN = OFF_WUP + SZ_WUP, OFF_WPG = OFF_WDN + SZ_WDN, OFF_WPP = OFF_WPG + SZ_WPG, SZ_WL = OFF_WPP + SZ_WPP;
constexpr size_t WS_W = CTL_BYTES;
constexpr size_t WS_PB = al4k(WS_W + DEPTH * SZ_WL);
constexpr size_t WS_ROPE = al4k(WS_PB + (size_t)DEPTH * S_ * PE * 2);
constexpr size_t HB_PADROWS = 256;
constexpr size_t WS_HB = al4k(WS_ROPE + (size_t)S_ * 32 * 4);
constexpr size_t WS_H32 = al4k(WS_HB + (size_t)(S_ + 2 * HB_PADROWS) * DM * 2);
constexpr size_t WS_H1 = al4k(WS_H32 + (size_t)S_ * DM * 4);
constexpr size_t WS_U = al4k(WS_H1 + (size_t)S_ * DM * 4);
constexpr size_t WS_PROJ = al4k(WS_U + (size_t)S_ * DM * 4);
constexpr size_t WS_XBCC = al4k(WS_PROJ + (size_t)S_ * NINP * 2);
constexpr size_t WS_KMEAN = al4k(WS_XBCC + (size_t)S_ * 1536 * 4);
constexpr size_t WS_YSSD = al4k(WS_KMEAN + (size_t)32 * 1024 * 4);
constexpr size_t WS_ATT = al4k(WS_YSSD + (size_t)S_ * 1024 * 4);
constexpr size_t WS_MIX = al4k(WS_ATT + (size_t)S_ * 1024 * 4);
constexpr size_t WS_HUP = al4k(WS_MIX + (size_t)S_ * DM * 2);
constexpr size_t WS_ACT = al4k(WS_HUP + (size_t)S_ * FF2 * 2);
constexpr size_t WS_SG = al4k(WS_ACT + (size_t)S_ * FF * 2);
constexpr size_t WS_PP = al4k(WS_SG + (size_t)S_ * DM * 2);
constexpr size_t WS_END = al4k(WS_PP + (size_t)S_ * DM * 2);
static_assert(WS_END < 1450000000ull, "workspace map exceeds the guaranteed d_ws size");
constexpr int CW_BAR = 4096;

constexpr int RING_BYTES = 131072;
constexpr int MISC_OFF = RING_BYTES + 20480;
constexpr int LDS_BYTES = MISC_OFF + 1024;
static_assert(LDS_BYTES <= 160 * 1024, "LDS");

typedef float f32x2v __attribute__((ext_vector_type(2)));
typedef unsigned u32x2v __attribute__((ext_vector_type(2)));
__device__ __forceinline__ float bf2f(unsigned short u) { return __uint_as_float((unsigned)u << 16); }
__device__ __forceinline__ float bflo(unsigned w) { return __uint_as_float(w << 16); }
__device__ __forceinline__ float bfhi(unsigned w) { return __uint_as_float(w & 0xffff0000u); }
__device__ __forceinline__ float silu_f(float x) { return x / (1.f + __expf(-x)); }
__device__ __forceinline__ float sigmoid_f(float x) { return 1.f / (1.f + __expf(-x)); }
__device__ __forceinline__ float softplus_f(float x) {
    const float u = __expf(-fabsf(x));
    const float l = (u < 0.02f) ? u * (1.f - u * (0.5f - u * (0.33333334f - 0.25f * u))) : __logf(1.f + u);
    return fmaxf(x, 0.f) + l;
}
__device__ __forceinline__ float wave_sum(float v) {
#pragma unroll
    for (int o = 1; o < 64; o <<= 1) v += __shfl_xor(v, o);
    return v;
}
__device__ __forceinline__ float wave_max(float v) {
#pragma unroll
    for (int o = 1; o < 64; o <<= 1) v = fmaxf(v, __shfl_xor(v, o));
    return v;
}

namespace pg8 {
struct EpiResF32 {
    static constexpr bool PERM = false, AFTER_DRAIN = false;
    float* C; const float* res; int ldc; float alpha;
    __device__ __forceinline__ void operator()(const f32x4 (&acc)[2][2][4][2], const Unit& u, int wr, int wc, int fr, int fq) const {
        const int row0 = u.pm * BM + wr * 64 + fr, col0 = u.pn * BM + wc * 32 + 4 * fq;
#pragma unroll
        for (int ai = 0; ai < 2; ++ai)
#pragma unroll
            for (int m = 0; m < 4; ++m) { const size_t off = (size_t)(row0 + ai * HALF + m * 16) * ldc + col0;
#pragma unroll
                for (int bj = 0; bj < 2; ++bj)
#pragma unroll
                    for (int n = 0; n < 2; ++n) { const f32x4 r = *(const f32x4*)(res + off + bj * HALF + n * 16); *(f32x4*)(C + off + bj * HALF + n * 16) = r * alpha + acc[ai][bj][m][n]; } }
    }
};
struct EpiDown {
    static constexpr bool PERM = false, AFTER_DRAIN = false;
    float* C; const float* res; const bf16_t* pp; const bf16_t* sg; int ldc; float alpha;
    __device__ __forceinline__ void operator()(const f32x4 (&acc)[2][2][4][2], const Unit& u, int wr, int wc, int fr, int fq) const {
        typedef unsigned u32x2 __attribute__((ext_vector_type(2)));
        const int row0 = u.pm * BM + wr * 64 + fr, col0 = u.pn * BM + wc * 32 + 4 * fq;
#pragma unroll
        for (int ai = 0; ai < 2; ++ai)
#pragma unroll
            for (int m = 0; m < 4; ++m) { const size_t off = (size_t)(row0 + ai * HALF + m * 16) * ldc + col0;
#pragma unroll
                for (int bj = 0; bj < 2; ++bj)
#pragma unroll
                    for (int n = 0; n < 2; ++n) { const size_t o = off + bj * HALF + n * 16;
                        const f32x4 r = *(const f32x4*)(res + o); const u32x2 a = *(const u32x2*)(pp + o), b = *(const u32x2*)(sg + o);
                        f32x4 pl; pl[0] = __uint_as_float(a.x << 16) * __uint_as_float(b.x << 16); pl[1] = __uint_as_float(a.x & 0xffff0000u) * __uint_as_float(b.x & 0xffff0000u);
                        pl[2] = __uint_as_float(a.y << 16) * __uint_as_float(b.y << 16); pl[3] = __uint_as_float(a.y & 0xffff0000u) * __uint_as_float(b.y & 0xffff0000u);
                        *(f32x4*)(C + o) = r * alpha + acc[ai][bj][m][n] + pl; } }
    }
};
template <bool SIG> struct EpiB16 {
    static constexpr bool PERM = true, AFTER_DRAIN = false;
    bf16_t* O; int ldc;
    __device__ __forceinline__ void operator()(const f32x4 (&acc)[2][2][4][2], const Unit& u, int wr, int wc, int fr, int fq) const {
        const int row0 = u.pm * BM + wr * 64 + fr, col0 = u.pn * BM + wc * 32 + 8 * fq;
#pragma unroll
        for (int ai = 0; ai < 2; ++ai)
#pragma unroll
            for (int m = 0; m < 4; ++m) { bf16_t* rowp = O + (size_t)(row0 + ai * HALF + m * 16) * ldc + col0;
#pragma unroll
                for (int bj = 0; bj < 2; ++bj) { f32x4 v0 = acc[ai][bj][m][0], v1 = acc[ai][bj][m][1];
                    if (SIG) {
#pragma unroll
                        for (int j = 0; j < 4; ++j) { v0[j] = 1.f / (1.f + __expf(-v0[j])); v1[j] = 1.f / (1.f + __expf(-v1[j])); } }
                    u32x4 w; w.x = cvt_pk_bf16(v0[0], v0[1]); w.y = cvt_pk_bf16(v0[2], v0[3]); w.z = cvt_pk_bf16(v1[0], v1[1]); w.w = cvt_pk_bf16(v1[2], v1[3]);
                    *(u32x4*)(rowp + bj * HALF) = w; } }
    }
};
}

struct Args {
    const float* in[22]; float* out; unsigned char* ws;
    int ph_lo, ph_hi;
};
struct Frame {
    LAS unsigned char* lds;
    int tid, lane, wave, G, gw, NGW;
    unsigned char* ws;
};

__device__ __forceinline__ void transpose_item(const float* __restrict__ W, int K, int N, bf16* __restrict__ WT, LAS float* scr, int kb, int nb, int lane) {
    const int k0 = 64 * kb, n0 = 32 * nb, nn = n0 + (lane & 31); const bool ok = nn < N;
#pragma unroll 8
    for (int i = 0; i < 32; ++i) { const int kk = 2 * i + (lane >> 5); scr[kk * 33 + (lane & 31)] = ok ? W[(size_t)(k0 + kk) * N + nn] : 0.f; }
    LDS_WAIT(); asm volatile("" ::: "memory");
    const int c = lane & 7;
#pragma unroll
    for (int j = 0; j < 4; ++j) { const int n = (lane >> 3) + 8 * j; const LAS float* s = scr + (8 * c) * 33 + n;
        v4u o; o.x = pk2(s[0 * 33], s[1 * 33]); o.y = pk2(s[2 * 33], s[3 * 33]); o.z = pk2(s[4 * 33], s[5 * 33]); o.w = pk2(s[6 * 33], s[7 * 33]);
        *(GAS v4u*)(WT + (size_t)(n0 + n) * K + k0 + 8 * c) = o; }
    LDS_WAIT(); asm volatile("" ::: "memory");
}
__device__ __forceinline__ void transpose_matrix(Frame& F, const float* W, int K, int N, int Np, bf16* WT) {
    LAS float* scr = (LAS float*)(F.lds + F.wave * 16384);
    const int nkb = K / 64, nnb = Np / 32, items = nkb * nnb;
    for (int it = F.gw; it < items; it += F.NGW) transpose_item(W, K, N, WT, scr, it / nnb, it % nnb, F.lane);
}
__device__ __forceinline__ void cvt_rows(Frame& F, const float* __restrict__ src, bf16* __restrict__ dst, size_t n8) {
    for (size_t i = (size_t)blockIdx.x * NTHR + F.tid; i < n8; i += (size_t)F.G * NTHR) {
        const f32x4 a = *(const f32x4*)(src + i * 8), b = *(const f32x4*)(src + i * 8 + 4);
        v4u o; o.x = pk2(a[0], a[1]); o.y = pk2(a[2], a[3]); o.z = pk2(b[0], b[1]); o.w = pk2(b[2], b[3]);
        *(v4u*)(dst + i * 8) = o; }
}

__device__ __forceinline__ void ln_row(const float* __restrict__ xr, const float* __restrict__ g, const float* __restrict__ b, float* __restrict__ o32, bf16* __restrict__ ob, int lane) {
    f32x4 v[8]; float s = 0.f;
#pragma unroll
    for (int j = 0; j < 8; ++j) { v[j] = *(const f32x4*)(xr + 4 * lane + 256 * j); s += (v[j][0] + v[j][1]) + (v[j][2] + v[j][3]); }
    const float mean = wave_sum(s) * (1.f / DM); float s2 = 0.f;
#pragma unroll
    for (int j = 0; j < 8; ++j) { v[j] = v[j] - mean; s2 += (v[j][0] * v[j][0] + v[j][1] * v[j][1]) + (v[j][2] * v[j][2] + v[j][3] * v[j][3]); }
    const float rstd = 1.f / sqrtf(wave_sum(s2) * (1.f / DM) + LN_EPS);
#pragma unroll
    for (int j = 0; j < 8; ++j) { const f32x4 gg = *(const f32x4*)(g + 4 * lane + 256 * j), bb = *(const f32x4*)(b + 4 * lane + 256 * j);
        const f32x4 o = v[j] * rstd * gg + bb;
        if (o32) *(f32x4*)(o32 + 4 * lane + 256 * j) = o;
        u32x2v w; w.x = pk2(o[0], o[1]); w.y = pk2(o[2], o[3]); *(u32x2v*)(ob + 4 * lane + 256 * j) = w; }
}

template <int PH> __global__ void __launch_bounds__(NTHR, 2) fwd(Args args) {
    extern __shared__ __attribute__((aligned(16))) unsigned char lds_raw[];
    Frame F;
    F.lds = (LAS unsigned char*)lds_raw;
    F.tid = threadIdx.x; F.lane = F.tid & 63; F.wave = __builtin_amdgcn_readfirstlane(F.tid >> 6);
    F.G = gridDim.x; F.gw = blockIdx.x * NWAVES + F.wave; F.NGW = F.G * NWAVES; F.ws = args.ws;
    volatile LAS unsigned* MISC = (volatile LAS unsigned*)(F.lds + MISC_OFF);
    for (int u = F.tid; u < (LDS_BYTES - MISC_OFF) / 4; u += NTHR) ((LAS unsigned*)(F.lds + MISC_OFF))[u] = 0u;
    __syncthreads();
    unsigned char* ws = args.ws;
    gu32* ctl = (gu32*)ws;
    (void)ctl; (void)MISC;
#define SEAM(f) do { } while (0)

    const float* x_in = args.in[0];
    bf16* HB = (bf16*)(ws + WS_HB) + HB_PADROWS * DM;
    float* H32 = (float*)(ws + WS_H32); float* H1 = (float*)(ws + WS_H1); float* U32 = (float*)(ws + WS_U);
    bf16* PROJ = (bf16*)(ws + WS_PROJ); float* XBCC = (float*)(ws + WS_XBCC); float* KMEAN = (float*)(ws + WS_KMEAN);
    float* YSSD = (float*)(ws + WS_YSSD); float* ATT = (float*)(ws + WS_ATT); bf16* MIX = (bf16*)(ws + WS_MIX);
    bf16* HUP = (bf16*)(ws + WS_HUP); bf16* ACT = (bf16*)(ws + WS_ACT); bf16* SG = (bf16*)(ws + WS_SG); bf16* PP = (bf16*)(ws + WS_PP);
    float* ROPE = (float*)(ws + WS_ROPE); bf16* PB = (bf16*)(ws + WS_PB);

    if constexpr (PH == 0) {
        for (int L = 0; L < DEPTH; ++L) {
            unsigned char* wl = ws + WS_W + (size_t)L * SZ_WL;
            transpose_matrix(F, args.in[3] + (size_t)L * DM * NIN, DM, NIN, NINP, (bf16*)wl);
            transpose_matrix(F, args.in[11] + (size_t)L * DM * DM, DM, DM, DM, (bf16*)(wl + OFF_WOUT));
            transpose_matrix(F, args.in[14] + (size_t)L * DM * FF2, DM, FF2, FF2, (bf16*)(wl + OFF_WUP));
            transpose_matrix(F, args.in[17] + (size_t)L * FF * DM, FF, DM, DM, (bf16*)(wl + OFF_WDN));
            transpose_matrix(F, args.in[18] + (size_t)L * DM * DM, DM, DM, DM, (bf16*)(wl + OFF_WPG));
            transpose_matrix(F, args.in[19] + (size_t)L * PE * DM, PE, DM, DM, (bf16*)(wl + OFF_WPP));
        }
        cvt_rows(F, x_in, HB, (size_t)S_ * DM / 8);
        cvt_rows(F, args.in[1], PB, (size_t)DEPTH * S_ * PE / 8);
        {
            const int* pos = (const int*)args.in[2];
            for (int i = blockIdx.x * NTHR + F.tid; i < S_ * 16; i += F.G * NTHR) {
                const int t = i >> 4, k = i & 15;
                const float inv = (float)(1.0 / exp2((double)k * (18.931568569324174 / 16.0)));
                const float ang = (float)pos[t] * inv;
                const double rev = (double)ang * 0.15915494309189535; const float fr = (float)(rev - rint(rev));
                ROPE[t * 32 + k] = __builtin_amdgcn_cosf(fr); ROPE[t * 32 + 16 + k] = __builtin_amdgcn_sinf(fr);
            }
        }
        SEAM(0);
    }

    if constexpr (PH >= 1) {
        const int L = args.ph_lo; const int fb = 0; (void)fb;
        unsigned char* wl = ws + WS_W + (size_t)L * SZ_WL;
        const float* hres = (L == 0) ? x_in : H32;

        if constexpr (PH == 1) {
            pg8::Gemm g{HB, (const bf16*)wl, S_, NINP, DM}; pg8::StaticOrder So; So.init(S_, NINP, F.G, (int)blockIdx.x);
            pg8::EpiB16<false> E{PROJ, NINP};
            pg8::gemm_phase<pg8::EpiB16<false>, pg8::StaticOrder, true, true>(F.lds, g, So, E);
            SEAM(fb + 0);
        }
        if constexpr (PH == 2) {
            LAS float* red = (LAS float*)F.lds;
            for (int u = blockIdx.x; u < 512; u += F.G) {
                const int which = u & 1, h = (u >> 1) & 7, blk = u >> 4;
                bf16* base = PROJ + (size_t)(blk * 256) * NINP + (which ? C_K : C_Q) + h * 128;
                if (which) {
                    const int col = F.tid & 127, rg = F.tid >> 7; float s = 0.f;
                    for (int r = rg * 64; r < rg * 64 + 64; ++r) {
                        float v = bf2f(base[(size_t)r * NINP + col]);
                        if (col < 32) { const float pv = bf2f(base[(size_t)r * NINP + (col ^ 16)]); const float* tb = ROPE + (size_t)(blk * 256 + r) * 32;
                            const float c = tb[col & 15], sn = tb[16 + (col & 15)]; v = (col < 16) ? v * c - pv * sn : v * c + pv * sn; }
                        s += v; }
                    red[rg * 128 + col] = s;
                    __syncthreads();
                    if (F.tid < 128) KMEAN[(size_t)(blk * 8 + h) * 128 + F.tid] = (red[F.tid] + red[128 + F.tid] + red[256 + F.tid] + red[384 + F.tid]) * (1.f / 256.f);
                }
                __syncthreads();
                for (int q = F.tid; q < 4096; q += NTHR) { const int r = q >> 4, i = q & 15; const float* tb = ROPE + (size_t)(blk * 256 + r) * 32;
                    const float c = tb[i], sn = tb[16 + i]; bf16* p1 = base + (size_t)r * NINP + i; const float t1 = bf2f(p1[0]), t2 = bf2f(p1[16]);
                    p1[0] = (bf16)f2bf(t1 * c - t2 * sn); p1[16] = (bf16)f2bf(t2 * c + t1 * sn); }
                __syncthreads();
            }
            SEAM(fb + 1);
        }
        if constexpr (PH == 3) {
            const float* cw = args.in[5] + (size_t)L * 4 * 1536; const float* cb = args.in[6] + (size_t)L * 1536;
            for (int i = blockIdx.x * NTHR + F.tid; i < S_ * 192; i += F.G * NTHR) {
                const int t = i / 192, c0 = (i % 192) * 8; float o[8];
#pragma unroll
                for (int j = 0; j < 8; ++j) o[j] = cb[c0 + j];
#pragma unroll
                for (int k = 0; k < 4; ++k) { const int tt = t - 3 + k; if (tt >= 0) { const v4u w = *(const v4u*)(PROJ + (size_t)tt * NINP + C_X + c0); const float* wk = cw + k * 1536 + c0;
                        o[0] += wk[0] * bflo(w.x); o[1] += wk[1] * bfhi(w.x); o[2] += wk[2] * bflo(w.y); o[3] += wk[3] * bfhi(w.y);
                        o[4] += wk[4] * bflo(w.z); o[5] += wk[5] * bfhi(w.z); o[6] += wk[6] * bflo(w.w); o[7] += wk[7] * bfhi(w.w); } }
                f32x4 a, b; a[0] = silu_f(o[0]); a[1] = silu_f(o[1]); a[2] = silu_f(o[2]); a[3] = silu_f(o[3]); b[0] = silu_f(o[4]); b[1] = silu_f(o[5]); b[2] = silu_f(o[6]); b[3] = silu_f(o[7]);
                *(f32x4*)(XBCC + (size_t)t * 1536 + c0) = a; *(f32x4*)(XBCC + (size_t)t * 1536 + c0 + 4) = b; }
            SEAM(fb + 2);
        }
        if constexpr (PH == 4) {
            if (blockIdx.x < 16) {
                const int h = blockIdx.x, g = h >> 3, p = F.tid >> 3, ng = F.tid & 7;
                const float a = -__expf(args.in[8][L * 16 + h]), dtb = args.in[7][L * 16 + h], Dh = args.in[9][L * 16 + h];
                LAS float* lb = (LAS float*)F.lds;
                float st[16];
#pragma unroll
                for (int j = 0; j < 16; ++j) st[j] = 0.f;
                for (int t0 = 0; t0 < S_; t0 += 32) {
                    __syncthreads();
                    for (int idx = F.tid; idx < 32 * 321; idx += NTHR) { const int tok = idx / 321, c = idx - tok * 321; const float* xr = XBCC + (size_t)(t0 + tok) * 1536; float v;
                        if (c < 64) v = xr[h * 64 + c]; else if (c < 192) v = xr[1024 + g * 128 + (c - 64)]; else if (c < 320) v = xr[1280 + g * 128 + (c - 192)];
                        else v = softplus_f(bf2f(PROJ[(size_t)(t0 + tok) * NINP + C_DT + h]) + dtb);
                        lb[tok * 324 + c] = v; }
                    __syncthreads();
                    for (int tok = 0; tok < 32; ++tok) {
                        const LAS float* r = lb + tok * 324; const float dt = r[320], xv = r[p], dA = __expf(dt * a), dx = dt * xv; float y = 0.f;
#pragma unroll
                        for (int q4 = 0; q4 < 4; ++q4) { const f32x4 Bv = *(const LAS f32x4*)(r + 64 + 16 * ng + 4 * q4), Cv = *(const LAS f32x4*)(r + 192 + 16 * ng + 4 * q4);
#pragma unroll
                            for (int j = 0; j < 4; ++j) { st[4 * q4 + j] = dA * st[4 * q4 + j] + dx * Bv[j]; y += Cv[j] * st[4 * q4 + j]; } }
                        y += __shfl_xor(y, 1); y += __shfl_xor(y, 2); y += __shfl_xor(y, 4);
                        if (ng == 0) YSSD[(size_t)(t0 + tok) * 1024 + h * 64 + p] = y + Dh * xv;
                    }
                }
                __syncthreads();
            }
            {
                LAS float* pbuf = (LAS float*)(F.lds + 65536) + F.wave * 1024;
                for (int task = F.gw; task < S_ * 8; task += F.NGW) {
                    const int s = task >> 3, h = task & 7, qb = s >> 8, lane = F.lane;
                    v4u qp[16]; { const v4u* qrow = (const v4u*)(PROJ + (size_t)s * NINP + C_Q + h * 128);
#pragma unroll
                        for (int i = 0; i < 16; ++i) qp[i] = qrow[i]; }
                    float gate = -INFINITY;
                    if (lane < qb) { const f32x4* km = (const f32x4*)(KMEAN + (size_t)(lane * 8 + h) * 128); float acc = 0.f;
#pragma unroll
                        for (int i = 0; i < 16; ++i) { const f32x4 k0 = km[2 * i], k1 = km[2 * i + 1];
                            acc += bflo(qp[i].x) * k0[0] + bfhi(qp[i].x) * k0[1] + bflo(qp[i].y) * k0[2] + bfhi(qp[i].y) * k0[3]
                                 + bflo(qp[i].z) * k1[0] + bfhi(qp[i].z) * k1[1] + bflo(qp[i].w) * k1[2] + bfhi(qp[i].w) * k1[3]; }
                        gate = acc; }
                    int sel[3];
#pragma unroll
                    for (int r = 0; r < 3; ++r) { float v = gate; int idx = lane;
#pragma unroll
                        for (int o = 32; o >= 1; o >>= 1) { const float ov = __shfl_xor(v, o); const int oi = __shfl_xor(idx, o); const bool take = (ov > v) || (ov == v && oi < idx); v = take ? ov : v; idx = take ? oi : idx; }
                        sel[r] = idx; if (lane == idx) gate = -INFINITY; }
                    const int nsel = qb < 3 ? qb : 3; const int s0 = sel[0], s1 = sel[1], s2 = sel[2];
                    float m = -INFINITY;
#pragma unroll 1
                    for (int bi = 0; bi < 4; ++bi) {
                        const bool active = (bi == 3) || (bi < nsel); const int blk = (bi == 3) ? qb : (bi == 0 ? s0 : (bi == 1 ? s1 : s2));
#pragma unroll 1
                        for (int i = 0; i < 4; ++i) { float scv = -INFINITY;
                            if (active) { const int key = blk * 256 + lane + 64 * i; const v4u* kr = (const v4u*)(PROJ + (size_t)key * NINP + C_K + h * 128); float acc = 0.f;
#pragma unroll
                                for (int w = 0; w < 16; ++w) { const v4u kk = kr[w];
                                    acc += bflo(qp[w].x) * bflo(kk.x) + bfhi(qp[w].x) * bfhi(kk.x) + bflo(qp[w].y) * bflo(kk.y) + bfhi(qp[w].y) * bfhi(kk.y)
                                         + bflo(qp[w].z) * bflo(kk.z) + bfhi(qp[w].z) * bfhi(kk.z) + bflo(qp[w].w) * bflo(kk.w) + bfhi(qp[w].w) * bfhi(kk.w); }
                                scv = (bi == 3 && key > s) ? -INFINITY : acc * 0.08838834764831845f; }
                            pbuf[bi * 256 + 64 * i + lane] = scv; m = fmaxf(m, scv); } }
                    m = wave_max(m); float l = 0.f;
#pragma unroll 1
                    for (int j = 0; j < 16; ++j) { const float pr = __expf(pbuf[64 * j + lane] - m); l += pr; pbuf[64 * j + lane] = pr; }
                    l = wave_sum(l);
                    LDS_WAIT(); asm volatile("" ::: "memory");
                    float o0 = 0.f, o1 = 0.f;
#pragma unroll 1
                    for (int bi = 0; bi < 4; ++bi) { const bool active = (bi == 3) || (bi < nsel); const int blk = (bi == 3) ? qb : (bi == 0 ? s0 : (bi == 1 ? s1 : s2));
                        if (active) { const bf16* vb = PROJ + (size_t)(blk * 256) * NINP + C_V + h * 128 + 2 * lane;
#pragma unroll 4
                            for (int kk = 0; kk < 256; ++kk) { const float pk = pbuf[bi * 256 + kk]; const unsigned w = *(const unsigned*)(vb + (size_t)kk * NINP); o0 += pk * bflo(w); o1 += pk * bfhi(w); } } }
                    const float il = 1.f / l; f32x2v ov; ov.x = o0 * il; ov.y = o1 * il;
                    *(f32x2v*)(ATT + (size_t)s * 1024 + h * 128 + 2 * lane) = ov;
                    LDS_WAIT(); asm volatile("" ::: "memory");
                }
            }
            SEAM(fb + 3);
        }
        if constexpr (PH == 5) {
            const float* ag = args.in[4] + (size_t)L * 1024; const float* sgn = args.in[10] + (size_t)L * 1024;
            for (int t = F.gw; t < S_; t += F.NGW) { const int lane = F.lane;
                f32x4 v[4]; float ss = 0.f;
#pragma unroll
                for (int j = 0; j < 4; ++j) { v[j] = *(const f32x4*)(ATT + (size_t)t * 1024 + 4 * lane + 256 * j); ss += (v[j][0] * v[j][0] + v[j][1] * v[j][1]) + (v[j][2] * v[j][2] + v[j][3] * v[j][3]); }
                const float rs = 1.f / sqrtf(wave_sum(ss) * (1.f / 1024.f) + RMS_EPS);
#pragma unroll
                for (int j = 0; j < 4; ++j) { const f32x4 gg = *(const f32x4*)(ag + 4 * lane + 256 * j); const f32x4 o = v[j] * rs * gg; u32x2v w; w.x = pk2(o[0], o[1]); w.y = pk2(o[2], o[3]);
                    *(u32x2v*)(MIX + (size_t)t * DM + 4 * lane + 256 * j) = w; }
                float s0 = 0.f, s1 = 0.f;
#pragma unroll
                for (int j = 0; j < 4; ++j) { const f32x4 y = *(const f32x4*)(YSSD + (size_t)t * 1024 + 4 * lane + 256 * j); const u32x2v zz = *(const u32x2v*)(PROJ + (size_t)t * NINP + C_Z + 4 * lane + 256 * j);
                    f32x4 o; o[0] = y[0] * silu_f(bflo(zz.x)); o[1] = y[1] * silu_f(bfhi(zz.x)); o[2] = y[2] * silu_f(bflo(zz.y)); o[3] = y[3] * silu_f(bfhi(zz.y)); v[j] = o;
                    const float q = (o[0] * o[0] + o[1] * o[1]) + (o[2] * o[2] + o[3] * o[3]); if (j < 2) s0 += q; else s1 += q; }
                const float r0 = 1.f / sqrtf(wave_sum(s0) * (1.f / 512.f) + RMS_EPS), r1 = 1.f / sqrtf(wave_sum(s1) * (1.f / 512.f) + RMS_EPS);
#pragma unroll
                for (int j = 0; j < 4; ++j) { const f32x4 gg = *(const f32x4*)(sgn + 4 * lane + 256 * j); const f32x4 o = v[j] * (j < 2 ? r0 : r1) * gg; u32x2v w; w.x = pk2(o[0], o[1]); w.y = pk2(o[2], o[3]);
                    *(u32x2v*)(MIX + (size_t)t * DM + 1024 + 4 * lane + 256 * j) = w; }
            }
            SEAM(fb + 4);
        }
        if constexpr (PH == 6) {
            pg8::Gemm g{MIX, (const bf16*)(wl + OFF_WOUT), S_, DM, DM}; pg8::StaticOrder So; So.init(S_, DM, F.G, (int)blockIdx.x);
            pg8::EpiResF32 E{U32, hres, DM, ALPHA};
            pg8::gemm_phase<pg8::EpiResF32, pg8::StaticOrder, true, true>(F.lds, g, So, E);
            SEAM(fb + 5);
        }
        if constexpr (PH == 7) {
            const float* g1 = args.in[12] + (size_t)L * DM; const float* b1 = args.in[13] + (size_t)L * DM;
            for (int t = F.gw; t < S_; t += F.NGW) ln_row(U32 + (size_t)t * DM, g1, b1, H1 + (size_t)t * DM, HB + (size_t)t * DM, F.lane);
            SEAM(fb + 6);
        }
        if constexpr (PH == 8) {
            pg8::Gemm g{HB, (const bf16*)(wl + OFF_WUP), S_, FF2, DM}; pg8::StaticOrder So; So.init(S_, FF2, F.G, (int)blockIdx.x);
            pg8::EpiB16<false> E{HUP, FF2};
            pg8::gemm_phase<pg8::EpiB16<false>, pg8::StaticOrder, true, true>(F.lds, g, So, E);
            SEAM(fb + 7);
        }
        if constexpr (PH == 9) {
            const float* cw = args.in[15] + (size_t)L * 3 * FF2; const float* cb = args.in[16] + (size_t)L * FF2;
            for (int i = blockIdx.x * NTHR + F.tid; i < S_ * (FF / 8); i += F.G * NTHR) {
                const int t = i / (FF / 8), c0 = (i % (FF / 8)) * 8; float og[8], ou[8];
#pragma unroll
                for (int j = 0; j < 8; ++j) { og[j] = cb[c0 + j]; ou[j] = cb[FF + c0 + j]; }
#pragma unroll
                for (int k = 0; k < 3; ++k) { const int tt = t - 2 + k; if (tt >= 0) { const v4u a = *(const v4u*)(HUP + (size_t)tt * FF2 + c0), b = *(const v4u*)(HUP + (size_t)tt * FF2 + FF + c0);
                        const float* wg = cw + (size_t)k * FF2 + c0; const float* wu = wg + FF;
                        og[0] += wg[0] * bflo(a.x); og[1] += wg[1] * bfhi(a.x); og[2] += wg[2] * bflo(a.y); og[3] += wg[3] * bfhi(a.y); og[4] += wg[4] * bflo(a.z); og[5] += wg[5] * bfhi(a.z); og[6] += wg[6] * bflo(a.w); og[7] += wg[7] * bfhi(a.w);
                        ou[0] += wu[0] * bflo(b.x); ou[1] += wu[1] * bfhi(b.x); ou[2] += wu[2] * bflo(b.y); ou[3] += wu[3] * bfhi(b.y); ou[4] += wu[4] * bflo(b.z); ou[5] += wu[5] * bfhi(b.z); ou[6] += wu[6] * bflo(b.w); ou[7] += wu[7] * bfhi(b.w); } }
                v4u o; o.x = pk2(silu_f(og[0]) * ou[0], silu_f(og[1]) * ou[1]); o.y = pk2(silu_f(og[2]) * ou[2], silu_f(og[3]) * ou[3]); o.z = pk2(silu_f(og[4]) * ou[4], silu_f(og[5]) * ou[5]); o.w = pk2(silu_f(og[6]) * ou[6], silu_f(og[7]) * ou[7]);
                *(v4u*)(ACT + (size_t)t * FF + c0) = o; }
            SEAM(fb + 8);
        }
        if constexpr (PH == 10) {
            { pg8::Gemm g{HB, (const bf16*)(wl + OFF_WPG), S_, DM, DM}; pg8::StaticOrder So; So.init(S_, DM, F.G, (int)blockIdx.x);
              pg8::EpiB16<true> E{SG, DM}; pg8::gemm_phase<pg8::EpiB16<true>, pg8::StaticOrder, true, true>(F.lds, g, So, E); }
            __syncthreads();
            { pg8::Gemm g{PB + (size_t)L * S_ * PE, (const bf16*)(wl + OFF_WPP), S_, DM, PE}; pg8::StaticOrder So; So.init(S_, DM, F.G, (int)blockIdx.x);
              pg8::EpiB16<false> E{PP, DM}; pg8::gemm_phase<pg8::EpiB16<false>, pg8::StaticOrder, true, true>(F.lds, g, So, E); }
            SEAM(fb + 9);
        }
        if constexpr (PH == 11) {
            pg8::Gemm g{ACT, (const bf16*)(wl + OFF_WDN), S_, DM, FF}; pg8::StaticOrder So; So.init(S_, DM, F.G, (int)blockIdx.x);
            pg8::EpiDown E{U32, H1, PP, SG, DM, ALPHA};
            pg8::gemm_phase<pg8::EpiDown, pg8::StaticOrder, true, true>(F.lds, g, So, E);
            SEAM(fb + 10);
        }
        if constexpr (PH == 12) {
            const float* g2 = args.in[20] + (size_t)L * DM; const float* b2 = args.in[21] + (size_t)L * DM;
            float* dst = (L == DEPTH - 1) ? args.out : H32;
            for (int t = F.gw; t < S_; t += F.NGW) ln_row(U32 + (size_t)t * DM, g2, b2, dst + (size_t)t * DM, HB + (size_t)t * DM, F.lane);
            SEAM(fb + 11);
        }
    }
#undef SEAM
}

#ifndef MK_ONE_LAUNCH
#define MK_ONE_LAUNCH 0
#endif
template <int PH> static void launch_ph(int grid, hipStream_t stream, const Args& a) { hipLaunchKernelGGL(fwd<PH>, dim3(grid), dim3(NTHR), LDS_BYTES, stream, a); }
template <int... I> static void launch_layer(int grid, hipStream_t stream, const Args& a, std::integer_sequence<int, I...>) { (launch_ph<I + 1>(grid, stream, a), ...); }
template <int... I> static void set_attrs(std::integer_sequence<int, I...>) { ((void)hipFuncSetAttribute((const void*)fwd<I>, hipFuncAttributeMaxDynamicSharedMemorySize, LDS_BYTES), ...); }
extern "C" void kernel_launch(void* const* d_in, const int* in_sizes, int n_in, void* d_out, int out_size, void* d_ws, size_t ws_size, hipStream_t stream) {
    static int grid = 0;
    if (grid == 0) {
        if (n_in != 22 || out_size != S_ * DM || ws_size < WS_END) { fprintf(stderr, "kernel_launch: unexpected shapes: n_in %d out %d ws %zu (need %zu)\n", n_in, out_size, ws_size, (size_t)WS_END); grid = -1; return; }
        int dev = 0, cus = 0, per_cu = 0;
        if (hipGetDevice(&dev) != hipSuccess || hipDeviceGetAttribute(&cus, hipDeviceAttributeMultiprocessorCount, dev) != hipSuccess) { grid = -1; return; }
        set_attrs(std::make_integer_sequence<int, NPH + 1>{});
        (void)per_cu; (void)hipGetLastError();
        grid = cus;
    }
    if (grid < 0) return;
    (void)hipMemsetAsync(d_ws, 0, CTL_BYTES, stream);
    Args a{};
    for (int i = 0; i < 22; ++i) a.in[i] = (const float*)d_in[i];
    a.out = (float*)d_out; a.ws = (unsigned char*)d_ws;
    const int nflat = 1 + NPH * DEPTH;
    (void)nflat;
    a.ph_lo = 0; a.ph_hi = 0; launch_ph<0>(grid, stream, a);
    for (int L = 0; L < DEPTH; ++L) { a.ph_lo = L; launch_layer(grid, stream, a, std::make_integer_sequence<int, NPH>{}); }
    const hipError_t le = hipPeekAtLastError();
    if (le != hipSuccess) fprintf(stderr, "kernel_launch: launch failed: %s\n", hipGetErrorName(le));
}
```

```cpp
#include <hip/hip_runtime.h>
#include <cstdio>
#include <cstdint>
#include <cmath>
#include <utility>
namespace pg8 {
#define PG8_LAS __attribute__((address_space(3)))
typedef unsigned short bf16_t;
typedef short bf16x8 __attribute__((ext_vector_type(8)));
typedef float f32x4 __attribute__((ext_vector_type(4)));
typedef unsigned u32x4 __attribute__((ext_vector_type(4)));
constexpr int BM = 256, BK = 64, HALF = 128, HTB = HALF * BK * 2  , STAGE_BYTES = 8 * HTB, NXCD = 8, WGM = 8;

__host__ __device__ __forceinline__ int lds_byte(int r, int c) { const int st = (r >> 4) * 2 + (c >> 5), rr = r & 15, cc = c & 31, ob = rr * 64 + cc * 2; return st * 1024 + (ob ^ (((ob >> 9) & 1) << 5)); }
__host__ __device__ __forceinline__ void stage_rc(int b, int& R, int& C) { const int st = b / 1024, sb = b % 1024, swz = sb ^ (((sb >> 9) & 1) << 5); R = (st >> 1) * 16 + swz / 64; C = (st & 1) * 32 + (swz % 64) / 2; }
__host__ __device__ __forceinline__ int perm32(int rho) { const int n = rho >> 4, i = rho & 15; return 8 * (i >> 2) + 4 * n + (i & 3); }

struct Unit { int pm, pn; };
struct Gemm { const bf16_t* A; const bf16_t* Bt; int M, N, K; };

struct StaticOrder {
    int nM, nN, nwg, G, c;
    __host__ __device__ void init(int M, int N, int G_, int c_) { nM = M / BM; nN = N / BM; nwg = nM * nN; G = G_; c = c_; }
    __host__ __device__ bool next(int i, Unit& u) const {
        const long L = (long)i * G + c; if (L >= nwg) return false;
        int wgid = (int)L; { const int q = nwg / NXCD, r = nwg % NXCD, xcd = wgid % NXCD, off = wgid / NXCD; wgid = (xcd < r ? xcd * (q + 1) : r * (q + 1) + (xcd - r) * q) + off; }
        const int nig = WGM * nN, gid = wgid / nig, fm = gid * WGM, gsz = (nM - fm) < WGM ? (nM - fm) : WGM;
        u.pm = fm + ((wgid % nig) % gsz); u.pn = (wgid % nig) / gsz; return true;
    }
    __device__ __forceinline__ void a_ready(const Unit&) const {}
    __device__ __forceinline__ void done(const Unit&) const {}
};

__device__ __forceinline__ unsigned cvt_pk_bf16(float lo, float hi) { unsigned r; asm volatile("v_cvt_pk_bf16_f32 %0, %1, %2" : "=v"(r) : "v"(lo), "v"(hi)); return r; }
typedef float f32x2 __attribute__((ext_vector_type(2)));
__device__ __forceinline__ f32x2 gelu_pk(f32x2 v) {
    const f32x2 av = __builtin_elementwise_abs(v), d = av * 0.2316418882f + 1.0f;
    f32x2 t; t.x = __builtin_amdgcn_rcpf(d.x); t.y = __builtin_amdgcn_rcpf(d.y);
    f32x2 q = t * 0.5307027145f + (-0.7265760135f); q = q * t + 0.7107068705f; q = q * t + (-0.142248368f); q = q * t + 0.127414796f; q = q * t;
    const f32x2 s = (v * v) * (-0.72134752044f);
    f32x2 e; e.x = __builtin_amdgcn_exp2f(s.x); e.y = __builtin_amdgcn_exp2f(s.y);
    const f32x2 m = v * (q * e), r = v - m;
    f32x2 o; o.x = v.x < 0.f ? m.x : r.x; o.y = v.y < 0.f ? m.y : r.y; return o;
}

template <int ACT  > struct EpiBf16 {
    static constexpr bool PERM = true, AFTER_DRAIN = false; static_assert(ACT == 0 || ACT == 1, "EpiBf16: ACT is 0 (none) or 1 (gelu_pk)");
    bf16_t* O; int ldc; const float* bias; int split_cols; size_t split_stride; float scale0;
    __device__ __forceinline__ void operator()(const f32x4 (&acc)[2][2][4][2], const Unit& u, int wr, int wc, int fr, int fq) const {
        const int row0 = u.pm * BM + wr * 64 + fr; int colt = u.pn * BM; bf16_t* base = O;
        float sc = 1.f; if (split_cols) { const int t = colt / split_cols; base += (size_t)t * split_stride; colt -= t * split_cols; if (t == 0) sc = scale0; }
        const int col0 = colt + wc * 32 + 8 * fq, bcol0 = u.pn * BM + wc * 32 + 8 * fq;
        f32x4 bv[2][2];
#pragma unroll
        for (int bj = 0; bj < 2; ++bj)
#pragma unroll
            for (int n = 0; n < 2; ++n) bv[bj][n] = bias ? *(const f32x4*)(bias + bcol0 + bj * HALF + 4 * n) : (f32x4){0.f, 0.f, 0.f, 0.f};
#pragma unroll
        for (int ai = 0; ai < 2; ++ai)
#pragma unroll
            for (int m = 0; m < 4; ++m) { bf16_t* rowp = base + (size_t)(row0 + ai * HALF + m * 16) * ldc + col0;
#pragma unroll
                for (int bj = 0; bj < 2; ++bj) { f32x4 v0 = acc[ai][bj][m][0] + bv[bj][0], v1 = acc[ai][bj][m][1] + bv[bj][1];
                    if (ACT == 1) { f32x2 a = gelu_pk((f32x2){v0[0], v0[1]}), b = gelu_pk((f32x2){v0[2], v0[3]}), c = gelu_pk((f32x2){v1[0], v1[1]}), d = gelu_pk((f32x2){v1[2], v1[3]});
                        v0 = (f32x4){a.x, a.y, b.x, b.y}; v1 = (f32x4){c.x, c.y, d.x, d.y}; }
                    v0 = v0 * sc; v1 = v1 * sc; u32x4 w; w.x = cvt_pk_bf16(v0[0], v0[1]); w.y = cvt_pk_bf16(v0[2], v0[3]); w.z = cvt_pk_bf16(v1[0], v1[1]); w.w = cvt_pk_bf16(v1[2], v1[3]);
                    *(u32x4*)(rowp + bj * HALF) = w; } }
    }
};

struct PanelStats {
    unsigned* xbuf;
    unsigned* cnt;
    unsigned* tmo;
    int ntn; float eps;
    unsigned code;
    __device__ __forceinline__ bool run(const f32x4 (&v)[2][2][4][2], const Unit& u, int wr, int wc, int fr, int fq, PG8_LAS unsigned char* lds, int wid, int lane) const {
        typedef float f32x2v __attribute__((ext_vector_type(2)));
        PG8_LAS f32x2v* P = (PG8_LAS f32x2v*)lds;
        PG8_LAS f32x2v* S = (PG8_LAS f32x2v*)(lds + 8192);
        PG8_LAS unsigned* flag = (PG8_LAS unsigned*)(lds + 8192 + 2048);
#pragma unroll
        for (int ai = 0; ai < 2; ++ai)
#pragma unroll
            for (int m = 0; m < 4; ++m) {
                float s = 0.f;
#pragma unroll
                for (int bj = 0; bj < 2; ++bj)
#pragma unroll
                    for (int n = 0; n < 2; ++n) { const f32x4 x = v[ai][bj][m][n]; s += (x[0] + x[1]) + (x[2] + x[3]); }
                s += __shfl_xor(s, 16); s += __shfl_xor(s, 32);
                const float mw = s * (1.0f / 64.0f); float q = 0.f;
#pragma unroll
                for (int bj = 0; bj < 2; ++bj)
#pragma unroll
                    for (int n = 0; n < 2; ++n) { const f32x4 d = v[ai][bj][m][n] - mw; q += (d[0] * d[0] + d[1] * d[1]) + (d[2] * d[2] + d[3] * d[3]); }
                q += __shfl_xor(q, 16); q += __shfl_xor(q, 32);
                if (fq == 0) P[(ai * HALF + wr * 64 + m * 16 + fr) * 4 + wc] = (f32x2v){mw, q};
            }
        asm volatile("s_waitcnt lgkmcnt(0)" ::: "memory"); __builtin_amdgcn_s_barrier(); asm volatile("" ::: "memory");
#if defined(BROKEN_EXCHANGE_NO_WAIT)
#warning BROKEN CONTROL BUILD: the row-statistics exchange does not wait; results are wrong by design
        if (blockIdx.x >= 64) { const long long t0_ = clock64(); while (clock64() - t0_ < 60000) __builtin_amdgcn_s_sleep(8); }
#endif
        const int row = wid * 32 + (lane & 31);
        if (lane < 32) {
            const f32x2v a = P[row * 4 + 0], b = P[row * 4 + 1], c = P[row * 4 + 2], d = P[row * 4 + 3];
            const float mt = (a.x + b.x + c.x + d.x) * 0.25f;
            const float da = a.x - mt, db = b.x - mt, dc = c.x - mt, dd = d.x - mt;
            const float m2 = (a.y + b.y) + (c.y + d.y) + 64.0f * ((da * da + db * db) + (dc * dc + dd * dd));
            unsigned long long* slot = (unsigned long long*)xbuf + ((size_t)(u.pm * BM + row) * 4 + u.pn);
            __hip_atomic_store(slot, ((unsigned long long)__float_as_uint(m2) << 32) | __float_as_uint(mt), __ATOMIC_RELAXED, __HIP_MEMORY_SCOPE_AGENT);
        }
        asm volatile("s_waitcnt vmcnt(0)" ::: "memory");
        if (lane == 0) __hip_atomic_fetch_add(cnt + 64 * u.pm, 1u, __ATOMIC_RELAXED, __HIP_MEMORY_SCOPE_AGENT);
        if (wid == 0) {
            bool dead = false; const unsigned long long t0 = __builtin_amdgcn_s_memrealtime(); const unsigned want = 8u * (unsigned)ntn;
            for (;;) {
#if defined(BROKEN_EXCHANGE_NO_WAIT)
                break;
#endif
                if ((unsigned)__builtin_amdgcn_readfirstlane(__hip_atomic_load(cnt + 64 * u.pm, __ATOMIC_RELAXED, __HIP_MEMORY_SCOPE_AGENT)) >= want) break;
                if (__builtin_amdgcn_s_memrealtime() - t0 > 2000000ull) {
                    if (lane == 0) { unsigned expect = 0u; __hip_atomic_compare_exchange_strong(tmo + 1, &expect, code | (unsigned)(u.pm & 0xff), __ATOMIC_RELAXED, __ATOMIC_RELAXED, __HIP_MEMORY_SCOPE_AGENT);
                                     __hip_atomic_store(tmo, 1u, __ATOMIC_RELAXED, __HIP_MEMORY_SCOPE_AGENT); }
                    dead = true; break; }
                __builtin_amdgcn_s_sleep(2);
            }
            __builtin_amdgcn_fence(__ATOMIC_ACQUIRE, "agent");
            if (lane == 0) flag[0] = dead ? 1u : 0u;
        }
        asm volatile("s_waitcnt vmcnt(0) lgkmcnt(0)" ::: "memory"); __builtin_amdgcn_s_barrier(); asm volatile("" ::: "memory");
        const bool bad = flag[0] != 0u;
        if (lane < 32) {
            const unsigned long long* slot = (const unsigned long long*)xbuf + (size_t)(u.pm * BM + row) * 4; float mt[4], m2[4]; float ms = 0.f;
#pragma unroll
            for (int t = 0; t < 4; ++t) { if (t < ntn) { const unsigned long long w = __hip_atomic_load(slot + t, __ATOMIC_RELAXED, __HIP_MEMORY_SCOPE_AGENT); mt[t] = __uint_as_float((unsigned)w); m2[t] = __uint_as_float((unsigned)(w >> 32)); } else { mt[t] = 0.f; m2[t] = 0.f; } ms += mt[t]; }
            const float mean = ms / (float)ntn; float q = 0.f;
#pragma unroll
            for (int t = 0; t < 4; ++t) if (t < ntn) { const float dm = mt[t] - mean; q += m2[t] + 256.0f * dm * dm; }
            S[row] = (f32x2v){mean, 1.0f / sqrtf(q / (256.0f * (float)ntn) + eps)};
        }
        asm volatile("s_waitcnt lgkmcnt(0)" ::: "memory"); __builtin_amdgcn_s_barrier(); asm volatile("" ::: "memory");
        return bad;
    }
};
struct EpiLnRes {
    static constexpr bool PERM = false, AFTER_DRAIN = true;
    const float* base; float* out; int ldc; const float* bias; PanelStats st; unsigned poison;
    __device__ __forceinline__ void fused(f32x4 (&acc)[2][2][4][2], const Unit& u, int wr, int wc, int fr, int fq, PG8_LAS unsigned char* lds, int wid, int lane) const {
        typedef float f32x2v __attribute__((ext_vector_type(2)));
        const PG8_LAS f32x2v* S = (const PG8_LAS f32x2v*)(lds + 8192);
        const int col0 = u.pn * BM + wc * 32 + 4 * fq;
#pragma unroll
        for (int bj = 0; bj < 2; ++bj)
#pragma unroll
            for (int n = 0; n < 2; ++n) { const f32x4 bv = bias ? *(const f32x4*)(bias + col0 + bj * HALF + n * 16) : (f32x4){0.f, 0.f, 0.f, 0.f};
#pragma unroll
                for (int ai = 0; ai < 2; ++ai)
#pragma unroll
                    for (int m = 0; m < 4; ++m) acc[ai][bj][m][n] += bv; }
        f32x4 pre[4][2][2];
#pragma unroll
        for (int m = 0; m < 4; ++m) { const size_t off = (size_t)(u.pm * BM + wr * 64 + m * 16 + fr) * ldc + col0;
#pragma unroll
            for (int bj = 0; bj < 2; ++bj)
#pragma unroll
                for (int n = 0; n < 2; ++n) pre[m][bj][n] = *(const f32x4*)(base + off + bj * HALF + n * 16); }
        const bool bad = st.run(acc, u, wr, wc, fr, fq, lds, wid, lane) || poison != 0u;
        const float qnan = __builtin_nanf("");
#pragma unroll
        for (int ai = 0; ai < 2; ++ai)
#pragma unroll
            for (int m = 0; m < 4; ++m) { const int r = ai * HALF + wr * 64 + m * 16 + fr; const f32x2v sr = S[r]; const size_t off = (size_t)(u.pm * BM + r) * ldc + col0;
#pragma unroll
                for (int bj = 0; bj < 2; ++bj)
#pragma unroll
                    for (int n = 0; n < 2; ++n) { const f32x4 bs = ai == 0 ? pre[m][bj][n] : *(const f32x4*)(base + off + bj * HALF + n * 16); f32x4 o = bs + (acc[ai][bj][m][n] - sr.x) * sr.y;
                        if (bad) o = (f32x4){qnan, qnan, qnan, qnan}; *(f32x4*)(out + off + bj * HALF + n * 16) = o; }
                if (m & 1) asm volatile("" ::: "memory"); }
    }
};
struct EpiLnResLn {
    static constexpr bool PERM = false, AFTER_DRAIN = true;
    const float* base; float* out; bf16_t* xn; int ldc; const float* bias; PanelStats st1, st2; unsigned poison;
    __device__ __forceinline__ void fused(f32x4 (&acc)[2][2][4][2], const Unit& u, int wr, int wc, int fr, int fq, PG8_LAS unsigned char* lds, int wid, int lane) const {
        typedef float f32x2v __attribute__((ext_vector_type(2))); typedef unsigned u32x2v __attribute__((ext_vector_type(2)));
        const PG8_LAS f32x2v* S = (const PG8_LAS f32x2v*)(lds + 8192);
        const int col0 = u.pn * BM + wc * 32 + 4 * fq;
#pragma unroll
        for (int bj = 0; bj < 2; ++bj)
#pragma unroll
            for (int n = 0; n < 2; ++n) { const f32x4 bv = bias ? *(const f32x4*)(bias + col0 + bj * HALF + n * 16) : (f32x4){0.f, 0.f, 0.f, 0.f};
#pragma unroll
                for (int ai = 0; ai < 2; ++ai)
#pragma unroll
                    for (int m = 0; m < 4; ++m) acc[ai][bj][m][n] += bv; }
        bool bad = st1.run(acc, u, wr, wc, fr, fq, lds, wid, lane) || poison != 0u;
        const float qnan = __builtin_nanf("");
#pragma unroll
        for (int ai = 0; ai < 2; ++ai)
#pragma unroll
            for (int m = 0; m < 4; ++m) { const int r = ai * HALF + wr * 64 + m * 16 + fr; const f32x2v sr = S[r]; const size_t off = (size_t)(u.pm * BM + r) * ldc + col0;
#pragma unroll
                for (int bj = 0; bj < 2; ++bj)
#pragma unroll
                    for (int n = 0; n < 2; ++n) { const f32x4 bs = *(const f32x4*)(base + off + bj * HALF + n * 16); acc[ai][bj][m][n] = bs + (acc[ai][bj][m][n] - sr.x) * sr.y; }
                asm volatile("" : "+v"(acc[ai][0][m][0]), "+v"(acc[ai][0][m][1]), "+v"(acc[ai][1][m][0]), "+v"(acc[ai][1][m][1]));
                if (m & 1) asm volatile("" ::: "memory"); }
        const bool bad1 = bad;
        bad = st2.run(acc, u, wr, wc, fr, fq, lds, wid, lane) || bad;
#pragma unroll
        for (int ai = 0; ai < 2; ++ai)
#pragma unroll
            for (int m = 0; m < 4; ++m) { const int r = ai * HALF + wr * 64 + m * 16 + fr; const f32x2v sr = S[r]; const size_t off = (size_t)(u.pm * BM + r) * ldc + col0;
#pragma unroll
                for (int bj = 0; bj < 2; ++bj)
#pragma unroll
                    for (int n = 0; n < 2; ++n) { const f32x4 x1 = acc[ai][bj][m][n]; *(f32x4*)(out + off + bj * HALF + n * 16) = bad1 ? (f32x4){qnan, qnan, qnan, qnan} : x1;
                        const f32x4 o = (x1 - sr.x) * sr.y; u32x2v w; w.x = cvt_pk_bf16(o[0], o[1]); w.y = cvt_pk_bf16(o[2], o[3]);
                        if (bad) { w.x = 0x7fc07fc0u; w.y = 0x7fc07fc0u; } *(u32x2v*)(xn + off + bj * HALF + n * 16) = w; }
                asm volatile("" ::: "memory"); }
    }
};

template <class Epi, class Sched, bool ALIGN_EPI = false, bool SP2 = false>
__device__ __forceinline__ void gemm_phase(PG8_LAS unsigned char* lds, const Gemm g, const Sched& S, const Epi& E) {
    int tid_ = threadIdx.x; asm volatile("" : "+v"(tid_));
    const int tid = tid_, wid = __builtin_amdgcn_readfirstlane(tid >> 6), lane = tid & 63, wr = wid >> 2, wc = wid & 3, fr = lane & 15, fq = lane >> 4;
    const int K = g.K, nt = K / BK;
    unsigned voffA[2], voffB[2];
#pragma unroll
    for (int i = 0; i < 2; ++i) { int R, C; stage_rc(tid * 16 + i * 8192, R, C); const int Rb = Epi::PERM ? ((R & ~31) + perm32(R & 31)) : R;
        voffA[i] = (unsigned)(R * K + C) * 2u; voffB[i] = (unsigned)(Rb * K + C) * 2u; }
    const size_t kstep = (size_t)(BK * 2);
    const size_t hstep = (size_t)HALF * K * 2;
    const size_t tstep = 2 * hstep;
    const unsigned ldsw = (unsigned)wid * 1024u;
    const int aoff = lds_byte(wr * 64 + fr, fq * 8), boff = lds_byte(wc * 32 + fr, fq * 8);
#define PG8_SA(b, h) (((b) * 2 + (h)) * HTB)
#define PG8_SB(b, h) ((4 + (b) * 2 + (h)) * HTB)
#define PG8_STAGE(bufoff, gbase, voff) do { _Pragma("unroll") for (int _i = 0; _i < 2; ++_i) \
        __builtin_amdgcn_global_load_lds((const unsigned*)((const char*)(gbase) + (voff)[_i]), (PG8_LAS unsigned*)(lds + (bufoff) + ldsw + _i * 8192), 16, 0, 0); } while (0)
#define PG8_LDA(dst, b, h) do { _Pragma("unroll") for (int m = 0; m < 4; ++m) _Pragma("unroll") for (int k = 0; k < 2; ++k) dst[m][k] = *(const PG8_LAS bf16x8*)(lds + PG8_SA(b, h) + aoff + m * 2048 + k * 1024); } while (0)
#define PG8_LDB(dst, b, h) do { _Pragma("unroll") for (int n = 0; n < 2; ++n) _Pragma("unroll") for (int k = 0; k < 2; ++k) dst[n][k] = *(const PG8_LAS bf16x8*)(lds + PG8_SB(b, h) + boff + n * 2048 + k * 1024); } while (0)
#define PG8_MMA(ai, bj, At, Bt) do { __builtin_amdgcn_s_setprio(1); _Pragma("unroll") for (int m = 0; m < 4; ++m) _Pragma("unroll") for (int n = 0; n < 2; ++n) _Pragma("unroll") for (int k = 0; k < 2; ++k) \
        acc[ai][bj][m][n] = __builtin_amdgcn_mfma_f32_16x16x32_bf16(Bt[n][k], At[m][k], acc[ai][bj][m][n], 0, 0, 0); __builtin_amdgcn_s_setprio(0); } while (0)
#define PG8_WAIT_V(n) asm volatile("s_waitcnt vmcnt(" #n ")" ::: "memory")
#define PG8_WAIT_L(n) asm volatile("s_waitcnt lgkmcnt(" #n ")" ::: "memory")
#define PG8_BAR __builtin_amdgcn_s_barrier()
#define PG8_SCHED __builtin_amdgcn_sched_barrier(0)
    Unit cur, nxt; int ui = 0;
    if (!S.next(0, cur)) return;
    f32x4 acc[2][2][4][2];
#pragma unroll
    for (int a = 0; a < 2; ++a)
#pragma unroll
        for (int b = 0; b < 2; ++b)
#pragma unroll
            for (int m = 0; m < 4; ++m)
#pragma unroll
                for (int n = 0; n < 2; ++n) acc[a][b][m][n] = (f32x4){0.f, 0.f, 0.f, 0.f};
    bf16x8 At[4][2], B0[2][2], B1[2][2];
    const char* cA = (const char*)g.A + (size_t)cur.pm * tstep; const char* cB = (const char*)g.Bt + (size_t)cur.pn * tstep;
    S.a_ready(cur);
    if constexpr (SP2) {
        PG8_STAGE(PG8_SB(0, 0), cB, voffB); PG8_STAGE(PG8_SB(0, 1), cB + hstep, voffB); PG8_STAGE(PG8_SA(0, 0), cA, voffA); PG8_STAGE(PG8_SA(0, 1), cA + hstep, voffA);
        if (wr == 1) PG8_BAR;
        PG8_WAIT_V(2); PG8_BAR;
        PG8_STAGE(PG8_SB(1, 0), cB + kstep, voffB); PG8_STAGE(PG8_SA(1, 0), cA + kstep, voffA); PG8_STAGE(PG8_SB(1, 1), cB + hstep + kstep, voffB);
        PG8_WAIT_V(6); PG8_BAR;
    } else {
        PG8_STAGE(PG8_SB(0, 0), cB, voffB); PG8_STAGE(PG8_SA(0, 0), cA, voffA); PG8_STAGE(PG8_SB(0, 1), cB + hstep, voffB); PG8_STAGE(PG8_SA(0, 1), cA + hstep, voffA);
        if (wr == 1) PG8_BAR;
        PG8_WAIT_V(4); PG8_BAR;
        PG8_STAGE(PG8_SB(1, 0), cB + kstep, voffB); PG8_STAGE(PG8_SA(1, 0), cA + kstep, voffA); PG8_STAGE(PG8_SB(1, 1), cB + hstep + kstep, voffB);
        PG8_WAIT_V(6); PG8_BAR;
    }
    for (;;) {
        const bool has_next = S.next(ui + 1, nxt);
        const char* nA = has_next ? (const char*)g.A + (size_t)nxt.pm * tstep : cA; const char* nB = has_next ? (const char*)g.Bt + (size_t)nxt.pn * tstep : cB;
        for (int t = 0; t < nt; t += 2) {
            const bool last = (t == nt - 2);
            const char* a1 = cA + (size_t)(t + 1) * kstep;
            const char* a2 = last ? nA : cA + (size_t)(t + 2) * kstep; const char* b2 = last ? nB : cB + (size_t)(t + 2) * kstep;
            const char* a3 = a2 + kstep; const char* b3 = b2 + kstep;
            if (last && has_next) S.a_ready(nxt);
            if constexpr (SP2) {
            PG8_LDB(B0, 0, 0); PG8_LDB(B1, 0, 1); PG8_SCHED; PG8_LDA(At, 0, 0); PG8_STAGE(PG8_SA(1, 1), a1 + hstep, voffA);
            PG8_WAIT_V(8); PG8_WAIT_L(0); PG8_BAR; PG8_MMA(0, 0, At, B0); PG8_MMA(0, 1, At, B1); PG8_BAR; PG8_SCHED;
            PG8_LDA(At, 0, 1); PG8_STAGE(PG8_SB(0, 0), b2, voffB); PG8_STAGE(PG8_SB(0, 1), b2 + hstep, voffB); PG8_STAGE(PG8_SA(0, 0), a2, voffA);
            PG8_WAIT_V(8); PG8_WAIT_L(0); PG8_BAR; PG8_MMA(1, 0, At, B0); PG8_MMA(1, 1, At, B1); PG8_BAR; PG8_SCHED;
            PG8_LDB(B0, 1, 0); PG8_LDB(B1, 1, 1); PG8_SCHED; PG8_LDA(At, 1, 0); PG8_STAGE(PG8_SA(0, 1), a2 + hstep, voffA);
            PG8_WAIT_V(8); PG8_WAIT_L(0); PG8_BAR; PG8_MMA(0, 0, At, B0); PG8_MMA(0, 1, At, B1); PG8_BAR; PG8_SCHED;
            PG8_LDA(At, 1, 1); PG8_STAGE(PG8_SB(1, 0), b3, voffB); PG8_STAGE(PG8_SB(1, 1), b3 + hstep, voffB); PG8_STAGE(PG8_SA(1, 0), a3, voffA);
            PG8_WAIT_V(8); PG8_WAIT_L(0); PG8_BAR; PG8_MMA(1, 0, At, B0); PG8_MMA(1, 1, At, B1); PG8_BAR; PG8_SCHED;
            } else {
            PG8_LDB(B0, 0, 0); PG8_SCHED; PG8_LDA(At, 0, 0); PG8_STAGE(PG8_SA(1, 1), a1 + hstep, voffA);
            PG8_WAIT_L(8); PG8_BAR; PG8_WAIT_L(0); PG8_MMA(0, 0, At, B0); PG8_BAR; PG8_SCHED;
            PG8_LDB(B1, 0, 1); PG8_STAGE(PG8_SB(0, 0), b2, voffB);
            PG8_BAR; PG8_WAIT_L(0); PG8_MMA(0, 1, At, B1); PG8_BAR;
            PG8_LDA(At, 0, 1); PG8_STAGE(PG8_SA(0, 0), a2, voffA);
            PG8_BAR; PG8_WAIT_L(0); PG8_MMA(1, 0, At, B0); PG8_BAR; PG8_SCHED;
            PG8_STAGE(PG8_SB(0, 1), b2 + hstep, voffB);
            PG8_WAIT_V(6); PG8_BAR; PG8_MMA(1, 1, At, B1); PG8_BAR;
            PG8_LDB(B0, 1, 0); PG8_SCHED; PG8_LDA(At, 1, 0); PG8_STAGE(PG8_SA(0, 1), a2 + hstep, voffA);
            PG8_WAIT_L(8); PG8_BAR; PG8_WAIT_L(0); PG8_MMA(0, 0, At, B0); PG8_BAR; PG8_SCHED;
            PG8_LDB(B1, 1, 1); PG8_STAGE(PG8_SB(1, 0), b3, voffB);
            PG8_BAR; PG8_WAIT_L(0); PG8_MMA(0, 1, At, B1); PG8_BAR;
            PG8_LDA(At, 1, 1); PG8_STAGE(PG8_SA(1, 0), a3, voffA);
            PG8_BAR; PG8_WAIT_L(0); PG8_MMA(1, 0, At, B0); PG8_BAR; PG8_SCHED;
            PG8_STAGE(PG8_SB(1, 1), b3 + hstep, voffB);
            PG8_WAIT_V(6); PG8_BAR; PG8_MMA(1, 1, At, B1); PG8_BAR;
            }
        }
        if constexpr (ALIGN_EPI) { if (wr == 0) PG8_BAR; }
        if constexpr (!Epi::AFTER_DRAIN) { E(acc, cur, wr, wc, fr, fq); S.done(cur); }
        if (!has_next) break;
#pragma unroll
        for (int a = 0; a < 2; ++a)
#pragma unroll
            for (int b = 0; b < 2; ++b)
#pragma unroll
                for (int m = 0; m < 4; ++m)
#pragma unroll
                    for (int n = 0; n < 2; ++n) acc[a][b][m][n] = (f32x4){0.f, 0.f, 0.f, 0.f};
        cur = nxt; cA = nA; cB = nB; ++ui;
        if constexpr (ALIGN_EPI) { if (wr == 1) PG8_BAR; }
    }
    PG8_WAIT_V(0);
    if constexpr (!ALIGN_EPI) { if (wr == 0) PG8_BAR; }
    PG8_BAR;
    if constexpr (Epi::AFTER_DRAIN) { E.fused(acc, cur, wr, wc, fr, fq, lds, wid, lane); S.done(cur); }
#undef PG8_SA
#undef PG8_SB
#undef PG8_STAGE
#undef PG8_LDA
#undef PG8_LDB
#undef PG8_MMA
#undef PG8_WAIT_V
#undef PG8_WAIT_L
#undef PG8_BAR
#undef PG8_SCHED
}
}
#define GAS __attribute__((address_space(1)))
#define LAS __attribute__((address_space(3)))
typedef unsigned short bf16;
typedef unsigned v4u __attribute__((ext_vector_type(4)));
typedef float f32x4 __attribute__((ext_vector_type(4)));
typedef short bf16x8 __attribute__((ext_vector_type(8)));
typedef GAS unsigned gu32;
typedef GAS unsigned long long gu64;
#define RLX_AGENT __ATOMIC_RELAXED, __HIP_MEMORY_SCOPE_AGENT
#define LDS_WAIT() asm volatile("s_waitcnt lgkmcnt(0)" ::: "memory")
#define VM_WAIT() asm volatile("s_waitcnt vmcnt(0)" ::: "memory")
__device__ __forceinline__ unsigned long long rt() { return __builtin_amdgcn_s_memrealtime(); }
__device__ __forceinline__ unsigned f2bf(float f) { unsigned u = __builtin_bit_cast(unsigned, f); return (u + 0x7fffu + ((u >> 16) & 1u)) >> 16; }
__device__ __forceinline__ unsigned pk2(float lo, float hi) { return f2bf(lo) | (f2bf(hi) << 16); }

#define XB_TMO      128
#define XB_XCNT(j)  (256  + 64 * (j))
#define XB_XSUB(j)  (1280 + 64 * (j))
#define XB_XGEN(j)  (2304 + 64 * (j))
#define XB_TOP      3328
#define XB_TOPGEN   3392
#define XCD_BAR_WORDS 3456
#define XB_SPIN_CAP (1u << 18)

__device__ __forceinline__ unsigned xb_ld(unsigned* p)              { return __hip_atomic_load(p, __ATOMIC_RELAXED, __HIP_MEMORY_SCOPE_AGENT); }
__device__ __forceinline__ unsigned xb_add(unsigned* p, unsigned v) { return __hip_atomic_fetch_add(p, v, __ATOMIC_RELAXED, __HIP_MEMORY_SCOPE_AGENT); }
__device__ __forceinline__ unsigned xb_xcc_id() { return (unsigned)__builtin_amdgcn_s_getreg((3 << 11) | 20) & 0xFu; }
#define XB_SPIN(cond, bar) do { unsigned _sp = 0; while (cond) { __builtin_amdgcn_s_sleep(1); \
    if ((++_sp & 255u) == 0u) { if (xb_ld(&(bar)[XB_TMO])) break; if (_sp > XB_SPIN_CAP) { atomicAdd(&(bar)[XB_TMO], 1u); break; } } } } while (0)

struct XcdBarrier {
    unsigned* bar; unsigned x;
    volatile LAS unsigned* st;
};

__device__ __forceinline__ XcdBarrier xcd_barrier_post(unsigned* bar, volatile LAS unsigned* st) {
    XcdBarrier b; b.bar = bar; b.x = xb_xcc_id(); b.st = st;
    if (threadIdx.x == 0) (void)xb_add(&bar[XB_XCNT(b.x)], 1u);
    return b;
}
__device__ __forceinline__ void xcd_barrier_complete(unsigned* bar, unsigned x, unsigned& nloc, unsigned& nx) {
    const unsigned G = gridDim.x * gridDim.y * gridDim.z;
    unsigned sum, cnt, mine, sp = 0u;
    for (;;) {
        sum = 0u; cnt = 0u; mine = 0u;
#pragma unroll
        for (unsigned j = 0; j < 16; ++j) { const unsigned c = xb_ld(&bar[XB_XCNT(j)]); sum += c; cnt += (c > 0u) ? 1u : 0u; mine = (j == x) ? c : mine; }
        if (sum == G) break;
        __builtin_amdgcn_s_sleep(1);
        if ((++sp & 255u) == 0u) { if (xb_ld(&bar[XB_TMO])) break; if (sp > XB_SPIN_CAP) { atomicAdd(&bar[XB_TMO], 1u); break; } }
    }
    nloc = mine > 0u ? mine : 1u; nx = cnt > 0u ? cnt : 1u;
}

__device__ __forceinline__ void xcd_barrier(const XcdBarrier& b) {
    asm volatile("s_waitcnt vmcnt(0)" ::: "memory");
    __syncthreads();
    if (threadIdx.x == 0) {
        unsigned* bar = b.bar;
        __builtin_amdgcn_s_waitcnt(0);
        unsigned nloc = b.st[0], nx = b.st[1];
        if (nloc == 0u) { xcd_barrier_complete(bar, b.x, nloc, nx); b.st[0] = nloc; b.st[1] = nx; }
        const unsigned old = xb_add(&bar[XB_XSUB(b.x)], 1u);
        const unsigned gen = old / nloc;
        if (old + 1u == (gen + 1u) * nloc) {
            __builtin_amdgcn_fence(__ATOMIC_RELEASE, "agent");
            asm volatile("s_waitcnt vmcnt(0)" ::: "memory");
            const unsigned og = xb_add(&bar[XB_TOP], 1u);
            const unsigned tg = og / nx;
            if (og + 1u == (tg + 1u) * nx) xb_add(&bar[XB_TOPGEN], 1u);
            else XB_SPIN(xb_ld(&bar[XB_TOPGEN]) == tg, bar);
            __builtin_amdgcn_fence(__ATOMIC_ACQUIRE, "agent");
            xb_add(&bar[XB_XGEN(b.x)], 1u);
            asm volatile("s_waitcnt vmcnt(0)" ::: "memory");
        } else {
            XB_SPIN(xb_ld(&bar[XB_XGEN(b.x)]) == gen, bar);
            __builtin_amdgcn_fence(__ATOMIC_ACQUIRE, "agent");
            asm volatile("s_waitcnt vmcnt(0)" ::: "memory");
        }
    }
    __syncthreads();
}
constexpr int S_ = 8192, DM = 2048, DEPTH = 4;
constexpr int NIN = 5648, NINP = 5888;
constexpr int C_Q = 0, C_K = 1024, C_V = 2048, C_Z = 3072, C_X = 4096, C_DT = 5632;
constexpr int FF = 5632, FF2 = 11264, PE = 256;
constexpr float ALPHA = 1.681792830507429f;
constexpr float LN_EPS = 1e-5f, RMS_EPS = 1e-6f;
constexpr int NWAVES = 8, NTHR = 512;
constexpr int NPH = 13;

constexpr size_t al4k(size_t x) { return (x + 4095) & ~(size_t)4095; }
constexpr size_t CTL_BYTES = 1u << 20;
constexpr size_t SZ_WIN = (size_t)NINP * DM * 2, SZ_WOUT = (size_t)DM * DM * 2, SZ_WUP = (size_t)FF2 * DM * 2, SZ_WDN = (size_t)DM * FF * 2, SZ_WPG = (size_t)DM * DM * 2, SZ_WPP = (size_t)DM * PE * 2;
constexpr size_t OFF_WOUT = SZ_WIN, OFF_WUP = OFF_WOUT + SZ_WOUT, OFF_WDN = OFF_WUP + SZ_WUP, OFF_WPG = OFF_WDN + SZ_WDN, OFF_WPP = OFF_WPG + SZ_WPG, SZ_WL = OFF_WPP + SZ_WPP;
constexpr size_t WS_W = CTL_BYTES;
constexpr size_t WS_PB = al4k(WS_W + DEPTH * SZ_WL);
constexpr size_t WS_ROPE = al4k(WS_PB + (size_t)DEPTH * S_ * PE * 2);
constexpr size_t HB_PADROWS = 256;
constexpr size_t WS_HB = al4k(WS_ROPE + (size_t)S_ * 32 * 4);
constexpr size_t WS_H32 = al4k(WS_HB + (size_t)(S_ + 2 * HB_PADROWS) * DM * 2);
constexpr size_t WS_H1 = al4k(WS_H32 + (size_t)S_ * DM * 4);
constexpr size_t WS_U = al4k(WS_H1 + (size_t)S_ * DM * 4);
constexpr size_t WS_PROJ = al4k(WS_U + (size_t)S_ * DM * 4);
constexpr size_t WS_XBCC = al4k(WS_PROJ + (size_t)S_ * NINP * 2);
constexpr size_t WS_KMEAN = al4k(WS_XBCC + (size_t)S_ * 1536 * 4);
constexpr size_t WS_YSSD = al4k(WS_KMEAN + (size_t)32 * 1024 * 4);
constexpr size_t WS_ATT = al4k(WS_YSSD + (size_t)S_ * 1024 * 4);
constexpr size_t WS_MIX = al4k(WS_ATT + (size_t)S_ * 1024 * 4);
constexpr size_t WS_HUP = al4k(WS_MIX + (size_t)S_ * DM * 2);
constexpr size_t WS_ACT = al4k(WS_HUP + (size_t)S_ * FF2 * 2);
constexpr size_t WS_SG = al4k(WS_ACT + (size_t)S_ * FF * 2);
constexpr size_t WS_PP = al4k(WS_SG + (size_t)S_ * DM * 2);
constexpr size_t WS_STATES = al4k(WS_PP + (size_t)S_ * DM * 2);
constexpr size_t WS_SIN = al4k(WS_STATES + (size_t)32 * 16 * 8192 * 4);
constexpr size_t WS_LCS = al4k(WS_SIN + (size_t)32 * 16 * 8192 * 2);
constexpr size_t WS_DEC = al4k(WS_LCS + (size_t)32 * 16 * 256 * 4);
constexpr size_t WS_PART = al4k(WS_DEC + 4096);
constexpr size_t WS_PLSE = al4k(WS_PART + (size_t)S_ * 8 * 4 * 128 * 2);
constexpr size_t WS_LIST = al4k(WS_PLSE + (size_t)S_ * 8 * 4 * 4);
constexpr size_t WS_END = al4k(WS_LIST + (size_t)8 * 32 * 8192 * 4);
static_assert(WS_END < 1450000000ull, "workspace map exceeds the guaranteed d_ws size");
constexpr int CW_CNT = 8192;
constexpr int CW_BAR = 4096;

constexpr int RING_BYTES = 131072;
constexpr int MISC_OFF = RING_BYTES + 20480;
constexpr int LDS_BYTES = MISC_OFF + 1024;
static_assert(LDS_BYTES <= 160 * 1024, "LDS");

typedef float f32x2v __attribute__((ext_vector_type(2)));
typedef unsigned u32x2v __attribute__((ext_vector_type(2)));
typedef unsigned u32x4 __attribute__((ext_vector_type(4)));
__device__ __forceinline__ float bf2f(unsigned short u) { return __uint_as_float((unsigned)u << 16); }
__device__ __forceinline__ float bflo(unsigned w) { return __uint_as_float(w << 16); }
__device__ __forceinline__ float bfhi(unsigned w) { return __uint_as_float(w & 0xffff0000u); }
__device__ __forceinline__ float silu_f(float x) { return x / (1.f + __expf(-x)); }
__device__ __forceinline__ float sigmoid_f(float x) { return 1.f / (1.f + __expf(-x)); }
__device__ __forceinline__ float softplus_f(float x) {
    const float u = __expf(-fabsf(x));
    const float l = (u < 0.02f) ? u * (1.f - u * (0.5f - u * (0.33333334f - 0.25f * u))) : __logf(1.f + u);
    return fmaxf(x, 0.f) + l;
}
__device__ __forceinline__ float wave_sum(float v) {
#pragma unroll
    for (int o = 1; o < 64; o <<= 1) v += __shfl_xor(v, o);
    return v;
}
__device__ __forceinline__ float wave_max(float v) {
#pragma unroll
    for (int o = 1; o < 64; o <<= 1) v = fmaxf(v, __shfl_xor(v, o));
    return v;
}

namespace pg8 {
struct EpiResF32 {
    static constexpr bool PERM = false, AFTER_DRAIN = false;
    float* C; const float* res; int ldc; float alpha;
    __device__ __forceinline__ void operator()(const f32x4 (&acc)[2][2][4][2], const Unit& u, int wr, int wc, int fr, int fq) const {
        const int row0 = u.pm * BM + wr * 64 + fr, col0 = u.pn * BM + wc * 32 + 4 * fq;
#pragma unroll
        for (int ai = 0; ai < 2; ++ai)
#pragma unroll
            for (int m = 0; m < 4; ++m) { const size_t off = (size_t)(row0 + ai * HALF + m * 16) * ldc + col0;
#pragma unroll
                for (int bj = 0; bj < 2; ++bj)
#pragma unroll
                    for (int n = 0; n < 2; ++n) { const f32x4 r = *(const f32x4*)(res + off + bj * HALF + n * 16); *(f32x4*)(C + off + bj * HALF + n * 16) = r * alpha + acc[ai][bj][m][n]; } }
    }
};
struct EpiDown {
    static constexpr bool PERM = false, AFTER_DRAIN = false;
    float* C; const float* res; const bf16_t* pp; const bf16_t* sg; int ldc; float alpha;
    __device__ __forceinline__ void operator()(const f32x4 (&acc)[2][2][4][2], const Unit& u, int wr, int wc, int fr, int fq) const {
        typedef unsigned u32x2 __attribute__((ext_vector_type(2)));
        const int row0 = u.pm * BM + wr * 64 + fr, col0 = u.pn * BM + wc * 32 + 4 * fq;
#pragma unroll
        for (int ai = 0; ai < 2; ++ai)
#pragma unroll
            for (int m = 0; m < 4; ++m) { const size_t off = (size_t)(row0 + ai * HALF + m * 16) * ldc + col0;
#pragma unroll
                for (int bj = 0; bj < 2; ++bj)
#pragma unroll
                    for (int n = 0; n < 2; ++n) { const size_t o = off + bj * HALF + n * 16;
                        const f32x4 r = *(const f32x4*)(res + o); const u32x2 a = *(const u32x2*)(pp + o), b = *(const u32x2*)(sg + o);
                        f32x4 pl; pl[0] = __uint_as_float(a.x << 16) * __uint_as_float(b.x << 16); pl[1] = __uint_as_float(a.x & 0xffff0000u) * __uint_as_float(b.x & 0xffff0000u);
                        pl[2] = __uint_as_float(a.y << 16) * __uint_as_float(b.y << 16); pl[3] = __uint_as_float(a.y & 0xffff0000u) * __uint_as_float(b.y & 0xffff0000u);
                        *(f32x4*)(C + o) = r * alpha + acc[ai][bj][m][n] + pl; } }
    }
};
template <bool SIG> struct EpiB16 {
    static constexpr bool PERM = true, AFTER_DRAIN = false;
    bf16_t* O; int ldc;
    __device__ __forceinline__ void operator()(const f32x4 (&acc)[2][2][4][2], const Unit& u, int wr, int wc, int fr, int fq) const {
        const int row0 = u.pm * BM + wr * 64 + fr, col0 = u.pn * BM + wc * 32 + 8 * fq;
#pragma unroll
        for (int ai = 0; ai < 2; ++ai)
#pragma unroll
            for (int m = 0; m < 4; ++m) { bf16_t* rowp = O + (size_t)(row0 + ai * HALF + m * 16) * ldc + col0;
#pragma unroll
                for (int bj = 0; bj < 2; ++bj) { f32x4 v0 = acc[ai][bj][m][0], v1 = acc[ai][bj][m][1];
                    if (SIG) {
#pragma unroll
                        for (int j = 0; j < 4; ++j) { v0[j] = 1.f / (1.f + __expf(-v0[j])); v1[j] = 1.f / (1.f + __expf(-v1[j])); } }
                    u32x4 w; w.x = cvt_pk_bf16(v0[0], v0[1]); w.y = cvt_pk_bf16(v0[2], v0[3]); w.z = cvt_pk_bf16(v1[0], v1[1]); w.w = cvt_pk_bf16(v1[2], v1[3]);
                    *(u32x4*)(rowp + bj * HALF) = w; } }
    }
};
}

struct Args {
    const float* in[22]; float* out; unsigned char* ws;
    int ph_lo, ph_hi;
};
struct Frame {
    LAS unsigned char* lds;
    int tid, lane, wave, G, gw, NGW;
    unsigned char* ws;
};

__device__ __forceinline__ void transpose_item(const float* __restrict__ W, int K, int N, bf16* __restrict__ WT, LAS float* scr, int kb, int nb, int lane) {
    const int k0 = 64 * kb, n0 = 32 * nb, nn = n0 + (lane & 31); const bool ok = nn < N;
#pragma unroll 8
    for (int i = 0; i < 32; ++i) { const int kk = 2 * i + (lane >> 5); scr[kk * 33 + (lane & 31)] = ok ? W[(size_t)(k0 + kk) * N + nn] : 0.f; }
    LDS_WAIT(); asm volatile("" ::: "memory");
    const int c = lane & 7;
#pragma unroll
    for (int j = 0; j < 4; ++j) { const int n = (lane >> 3) + 8 * j; const LAS float* s = scr + (8 * c) * 33 + n;
        v4u o; o.x = pk2(s[0 * 33], s[1 * 33]); o.y = pk2(s[2 * 33], s[3 * 33]); o.z = pk2(s[4 * 33], s[5 * 33]); o.w = pk2(s[6 * 33], s[7 * 33]);
        *(GAS v4u*)(WT + (size_t)(n0 + n) * K + k0 + 8 * c) = o; }
    LDS_WAIT(); asm volatile("" ::: "memory");
}
__device__ __forceinline__ void transpose_matrix(Frame& F, const float* W, int K, int N, int Np, bf16* WT) {
    LAS float* scr = (LAS float*)(F.lds + F.wave * 16384);
    const int nkb = K / 64, nnb = Np / 32, items = nkb * nnb;
    for (int it = F.gw; it < items; it += F.NGW) transpose_item(W, K, N, WT, scr, it / nnb, it % nnb, F.lane);
}
__device__ __forceinline__ void cvt_rows(Frame& F, const float* __restrict__ src, bf16* __restrict__ dst, size_t n8) {
    for (size_t i = (size_t)blockIdx.x * NTHR + F.tid; i < n8; i += (size_t)F.G * NTHR) {
        const f32x4 a = *(const f32x4*)(src + i * 8), b = *(const f32x4*)(src + i * 8 + 4);
        v4u o; o.x = pk2(a[0], a[1]); o.y = pk2(a[2], a[3]); o.z = pk2(b[0], b[1]); o.w = pk2(b[2], b[3]);
        *(v4u*)(dst + i * 8) = o; }
}

__device__ __forceinline__ void ln_row(const float* __restrict__ xr, const float* __restrict__ g, const float* __restrict__ b, float* __restrict__ o32, bf16* __restrict__ ob, int lane) {
    f32x4 v[8]; float s = 0.f;
#pragma unroll
    for (int j = 0; j < 8; ++j) { v[j] = *(const f32x4*)(xr + 4 * lane + 256 * j); s += (v[j][0] + v[j][1]) + (v[j][2] + v[j][3]); }
    const float mean = wave_sum(s) * (1.f / DM); float s2 = 0.f;
#pragma unroll
    for (int j = 0; j < 8; ++j) { v[j] = v[j] - mean; s2 += (v[j][0] * v[j][0] + v[j][1] * v[j][1]) + (v[j][2] * v[j][2] + v[j][3] * v[j][3]); }
    const float rstd = 1.f / sqrtf(wave_sum(s2) * (1.f / DM) + LN_EPS);
#pragma unroll
    for (int j = 0; j < 8; ++j) { const f32x4 gg = *(const f32x4*)(g + 4 * lane + 256 * j), bb = *(const f32x4*)(b + 4 * lane + 256 * j);
        const f32x4 o = v[j] * rstd * gg + bb;
        if (o32) *(f32x4*)(o32 + 4 * lane + 256 * j) = o;
        u32x2v w; w.x = pk2(o[0], o[1]); w.y = pk2(o[2], o[3]); *(u32x2v*)(ob + 4 * lane + 256 * j) = w; }
}


typedef short bf16x8 __attribute__((ext_vector_type(8)));
typedef short s16x4 __attribute__((ext_vector_type(4)));
typedef float f32x16 __attribute__((ext_vector_type(16)));
typedef __bf16 bf16x2_t __attribute__((ext_vector_type(2)));
__device__ __forceinline__ unsigned cvtpk(float lo, float hi) { f32x2v v = {lo, hi}; bf16x2_t b = __builtin_convertvector(v, bf16x2_t); return __builtin_bit_cast(unsigned, b); }
__device__ __forceinline__ int crow(int r, int hi) { return (r & 3) + 8 * (r >> 2) + 4 * hi; }
#define MFMA32(a, b, c) __builtin_amdgcn_mfma_f32_32x32x16_bf16((a), (b), (c), 0, 0, 0)
__device__ __forceinline__ unsigned off_b(unsigned row, unsigned ch) { return 256u * row + 16u * (ch ^ (((row & 3) << 2) | ((row >> 2) & 3))); }
__device__ __forceinline__ s16x4 tr_rd(const LAS unsigned char* p) { typedef short v4i16_t __attribute__((ext_vector_type(4))); return __builtin_bit_cast(s16x4, __builtin_amdgcn_ds_read_tr16_b64_v4i16((LAS v4i16_t*)p)); }
__device__ __forceinline__ bf16x8 pack8(const f32x4& a, const f32x4& b) { u32x4 w; w.x = cvtpk(a[0], a[1]); w.y = cvtpk(a[2], a[3]); w.z = cvtpk(b[0], b[1]); w.w = cvtpk(b[2], b[3]); return __builtin_bit_cast(bf16x8, w); }
namespace ssd {
constexpr int XTP = 528;
constexpr int L_B = 0, L_X1 = 65536, L_X2 = L_X1 + 64 * XTP, L_DT = L_X2 + 64 * XTP, L_LC = L_DT + 1024, L_END = L_LC + 1024;
static_assert(L_END <= RING_BYTES + 20480, "ssd LDS map");
}

namespace att {
constexpr float SCALE = 0.088388347648318440f, C = SCALE * 1.4426950408889634f;
constexpr int SHM_T = 16384;
constexpr int L_K = 0, L_V = 65536, L_WS = 131072, L_DST = L_WS + 2048, L_PRE = L_DST + 1024;
#define KSWZ(row, colB) ((row) * 256 + ((colB) ^ (((row) & 7) << 4)))
#define SBAR() __builtin_amdgcn_sched_barrier(0)
__device__ __forceinline__ int v_st(int k, int c) { const int kk = (k & ~0xC) | ((k & 4) << 1) | ((k & 8) >> 1); return ((kk >> 3) * 4 + (c >> 5)) * 512 + ((kk & 7) * 32 + (c & 31)) * 2; }
__device__ __forceinline__ int v_rd_base(int lane) { return ((lane & 3) << 3) | (((lane >> 2) & 3) << 6) | (((lane >> 4) & 1) << 5) | (((lane >> 5) & 1) << 8); }
constexpr int v_rd_off(int d0, int ks, int half) { return d0 * 512 + ks * 4096 + half * 2048; }
template <int OFF> __device__ __forceinline__ s16x4 tr_read(int vb) { s16x4 r; asm volatile("ds_read_b64_tr_b16 %0, %1 offset:%2" : "=&v"(r) : "v"(vb), "i"(OFF) : "memory"); return r; }
template <bool CAUSAL> __device__ __forceinline__ void partialSM(f32x16& p0, f32x16& p1, float& m_reg, float& mn, float& alpha, int kbase, int qrel, int hi) {
    if (CAUSAL) {
#pragma unroll
        for (int r = 0; r < 16; ++r) { const int kv = kbase + crow(r, hi); if (kv > qrel) p0[r] = -INFINITY; if (kv + 32 > qrel) p1[r] = -INFINITY; } }
    float pmax = p0[0];
#pragma unroll
    for (int r = 1; r < 16; ++r) pmax = fmaxf(pmax, p0[r]);
#pragma unroll
    for (int r = 0; r < 16; ++r) pmax = fmaxf(pmax, p1[r]);
    { auto rr = __builtin_amdgcn_permlane32_swap(__float_as_uint(pmax), __float_as_uint(pmax), false, false); pmax = fmaxf(__uint_as_float(rr[0]), __uint_as_float(rr[1])); }
    if (__all(pmax <= m_reg)) { mn = m_reg; alpha = 1.f; }
    else { mn = fmaxf(m_reg, pmax); alpha = __builtin_amdgcn_exp2f((m_reg - mn) * C); m_reg = mn; }
    const float mnC = -mn * C;
#pragma unroll
    for (int r = 0; r < 16; ++r) p0[r] = fmaf(p0[r], C, mnC);
#pragma unroll
    for (int r = 0; r < 16; ++r) p1[r] = fmaf(p1[r], C, mnC);
#pragma unroll
    for (int r = 0; r < 16; ++r) p0[r] = __builtin_amdgcn_exp2f(p0[r]);
}
__device__ __forceinline__ void finishSM(f32x16& p0, f32x16& p1, float alpha, float& l_reg, bf16x8& pa0, bf16x8& pa1, bf16x8& pa2, bf16x8& pa3) {
#pragma unroll
    for (int r = 0; r < 16; ++r) p1[r] = __builtin_amdgcn_exp2f(p1[r]);
    float ps = 0;
#pragma unroll
    for (int r = 0; r < 16; ++r) ps += p0[r];
#pragma unroll
    for (int r = 0; r < 16; ++r) ps += p1[r];
    { auto rr = __builtin_amdgcn_permlane32_swap(__float_as_uint(ps), __float_as_uint(ps), false, false); ps = __uint_as_float(rr[0]) + __uint_as_float(rr[1]); }
    l_reg = l_reg * alpha + ps;
#define PK4(P, BASE, OUT) do { unsigned a0 = cvtpk(P[BASE + 0], P[BASE + 1]), a1 = cvtpk(P[BASE + 2], P[BASE + 3]);   \
    unsigned b0 = cvtpk(P[BASE + 4], P[BASE + 5]), b1 = cvtpk(P[BASE + 6], P[BASE + 7]);                              \
    auto r0 = __builtin_amdgcn_permlane32_swap(a0, b0, false, false); auto r1 = __builtin_amdgcn_permlane32_swap(a1, b1, false, false); \
    u32x4 w = {r0[0], r1[0], r0[1], r1[1]}; OUT = __builtin_bit_cast(bf16x8, w); } while (0)
    PK4(p0, 0, pa0); PK4(p0, 8, pa1); PK4(p1, 0, pa2); PK4(p1, 8, pa3);
#undef PK4
}
__device__ __forceinline__ void qkt(f32x16& p0, f32x16& p1, const LAS unsigned char* Ks, const bf16x8* qr, int r32, int hi) {
    p0 = f32x16{}; p1 = f32x16{};
#pragma unroll
    for (int d0 = 0; d0 < 8; ++d0) { const int cb = (d0 * 16 + hi * 8) * 2;
        const bf16x8 b0 = *(const LAS bf16x8*)(Ks + KSWZ(r32, cb));
        const bf16x8 b1 = *(const LAS bf16x8*)(Ks + KSWZ(32 + r32, cb));
        p0 = MFMA32(b0, qr[d0], p0); p1 = MFMA32(b1, qr[d0], p1); }
}
template <int D0> __device__ __forceinline__ void pv_one(f32x16& od, int vb, bf16x8 pa0, bf16x8 pa1, bf16x8 pa2, bf16x8 pa3) {
    const s16x4 l0 = tr_read<v_rd_off(D0, 0, 0)>(vb), h0 = tr_read<v_rd_off(D0, 0, 1)>(vb), l1 = tr_read<v_rd_off(D0, 1, 0)>(vb), h1 = tr_read<v_rd_off(D0, 1, 1)>(vb);
    const s16x4 l2 = tr_read<v_rd_off(D0, 2, 0)>(vb), h2 = tr_read<v_rd_off(D0, 2, 1)>(vb), l3 = tr_read<v_rd_off(D0, 3, 0)>(vb), h3 = tr_read<v_rd_off(D0, 3, 1)>(vb);
    asm volatile("s_waitcnt lgkmcnt(0)" ::: "memory"); SBAR();
#define PK(L, H) (bf16x8){L[0], L[1], L[2], L[3], H[0], H[1], H[2], H[3]}
    od = MFMA32(pa0, PK(l0, h0), od); od = MFMA32(pa1, PK(l1, h1), od); od = MFMA32(pa2, PK(l2, h2), od); od = MFMA32(pa3, PK(l3, h3), od);
#undef PK
}
__device__ __forceinline__ void pv_d0(f32x16* o, int vb, bf16x8 pa0, bf16x8 pa1, bf16x8 pa2, bf16x8 pa3) {
    pv_one<0>(o[0], vb, pa0, pa1, pa2, pa3); pv_one<1>(o[1], vb, pa0, pa1, pa2, pa3); pv_one<2>(o[2], vb, pa0, pa1, pa2, pa3); pv_one<3>(o[3], vb, pa0, pa1, pa2, pa3);
}
template <bool CAUSAL> __device__ __forceinline__ void unit(LAS unsigned char* lds, const bf16* __restrict__ proj, int h, int kv0, int my_q, int my_dst, bf16* __restrict__ part, float* __restrict__ plse, int tid) {
    const int wid = __builtin_amdgcn_readfirstlane(tid >> 6), lane = tid & 63, r32 = lane & 31, hi = lane >> 5;
    LAS float* wsf = (LAS float*)(lds + L_WS) + wid * 64; LAS int* dstw = (LAS int*)(lds + L_DST) + wid * 32;
    { const int sr = tid >> 4, sc = (tid & 15) * 8; const int vst0 = v_st(sr, sc), vst1 = v_st(32 + sr, sc), kc = sc * 2;
#pragma unroll
      for (int t = 0; t < 4; ++t) {
          const bf16* kp = proj + (size_t)(kv0 + 64 * t + sr) * NINP + C_K + h * 128 + sc; const bf16* vp = proj + (size_t)(kv0 + 64 * t + sr) * NINP + C_V + h * 128 + sc;
          const bf16x8 k0 = *(const bf16x8*)kp, k1 = *(const bf16x8*)(kp + (size_t)32 * NINP), v0 = *(const bf16x8*)vp, v1 = *(const bf16x8*)(vp + (size_t)32 * NINP);
          *(LAS bf16x8*)(lds + L_K + t * SHM_T + KSWZ(sr, kc)) = k0; *(LAS bf16x8*)(lds + L_K + t * SHM_T + KSWZ(32 + sr, kc)) = k1;
          *(LAS bf16x8*)(lds + L_V + t * SHM_T + vst0) = v0; *(LAS bf16x8*)(lds + L_V + t * SHM_T + vst1) = v1; } }
    bf16x8 qr[8];
    { const bf16* Qw = proj + (size_t)my_q * NINP + C_Q + h * 128 + hi * 8;
#pragma unroll
      for (int d0 = 0; d0 < 8; ++d0) qr[d0] = *(const bf16x8*)(Qw + d0 * 16); }
    if (hi == 0) dstw[r32] = my_dst;
    __syncthreads();
    float m_reg = -1e30f, l_reg = 0.f; f32x16 o[4] = {};
    const int vb0 = (int)(unsigned)(uintptr_t)(lds + L_V) + v_rd_base(lane);
    LAS float* al_l = wsf + 32; LAS float* li_l = wsf;
    const int qrel = wid * 32 + r32;
#define RESC(a) do { if (__any((a) < 1.f)) { if (hi == 0) al_l[r32] = (a); asm volatile("s_waitcnt lgkmcnt(0)" ::: "memory"); \
    _Pragma("unroll") for (int d = 0; d < 4; ++d) _Pragma("unroll") for (int r = 0; r < 16; ++r) o[d][r] *= al_l[crow(r, hi)]; } } while (0)
    const int ntile = CAUSAL ? (wid >> 1) + 1 : 4;
#pragma unroll 1
    for (int t = 0; t < ntile; ++t) {
        f32x16 p0, p1; float mn, alpha; bf16x8 pa0, pa1, pa2, pa3;
        qkt(p0, p1, lds + L_K + t * SHM_T, qr, r32, hi);
        partialSM<CAUSAL>(p0, p1, m_reg, mn, alpha, 64 * t, qrel, hi);
        RESC(alpha);
        finishSM(p0, p1, alpha, l_reg, pa0, pa1, pa2, pa3); SBAR();
        pv_d0(o, vb0 + t * SHM_T, pa0, pa1, pa2, pa3);
    }
#undef RESC
    if (hi == 0) { li_l[r32] = l_reg; if (my_dst >= 0) plse[my_dst] = m_reg * C + __builtin_amdgcn_logf(l_reg); }
    asm volatile("s_waitcnt lgkmcnt(0)" ::: "memory");
    float rli[16];
#pragma unroll
    for (int r = 0; r < 16; ++r) rli[r] = __builtin_amdgcn_rcpf(li_l[crow(r, hi)]);
    __syncthreads();
    { LAS unsigned short* stg = (LAS unsigned short*)(lds + L_K) + wid * 4096;
#pragma unroll
      for (int r = 0; r < 16; ++r) { const int orow = crow(r, hi);
#pragma unroll
          for (int d0 = 0; d0 < 4; ++d0) stg[orow * 128 + d0 * 32 + r32] = (unsigned short)f2bf(o[d0][r] * rli[r]); }
      asm volatile("s_waitcnt lgkmcnt(0)" ::: "memory");
#pragma unroll
      for (int i = 0; i < 8; ++i) { const int idx = i * 64 + lane, row = idx >> 4, ch = idx & 15; const int d = dstw[row];
          const u32x4 v = *(const LAS u32x4*)(stg + row * 128 + ch * 8); if (d >= 0) *(u32x4*)(part + (size_t)d * 128 + ch * 8) = v; } }
    __syncthreads();
}
#undef SBAR
}
template <int PH> __global__ void __launch_bounds__(NTHR, 2) fwd(Args args) {
    extern __shared__ __attribute__((aligned(16))) unsigned char lds_raw[];
    Frame F;
    F.lds = (LAS unsigned char*)lds_raw;
    F.tid = threadIdx.x; F.lane = F.tid & 63; F.wave = __builtin_amdgcn_readfirstlane(F.tid >> 6);
    F.G = gridDim.x; F.gw = blockIdx.x * NWAVES + F.wave; F.NGW = F.G * NWAVES; F.ws = args.ws;
    volatile LAS unsigned* MISC = (volatile LAS unsigned*)(F.lds + MISC_OFF);
    for (int u = F.tid; u < (LDS_BYTES - MISC_OFF) / 4; u += NTHR) ((LAS unsigned*)(F.lds + MISC_OFF))[u] = 0u;
    __syncthreads();
    unsigned char* ws = args.ws;
    gu32* ctl = (gu32*)ws;
    XcdBarrier bar; bar.bar = (unsigned*)ctl + CW_BAR; bar.x = 0; bar.st = nullptr;
    if constexpr (PH == -1) bar = xcd_barrier_post((unsigned*)ctl + CW_BAR, MISC + 8);
#define SEAM(f) do { if constexpr (PH == -1) xcd_barrier(bar); } while (0)
#define PHASE_BEGIN() do { int t_ = threadIdx.x; asm volatile("" : "+v"(t_)); F.tid = t_; F.lane = t_ & 63; F.wave = __builtin_amdgcn_readfirstlane(t_ >> 6); int b_ = blockIdx.x; asm volatile("" : "+s"(b_)); F.gw = b_ * NWAVES + F.wave; } while (0)

    const float* x_in = args.in[0];
    bf16* HB = (bf16*)(ws + WS_HB) + HB_PADROWS * DM;
    float* H32 = (float*)(ws + WS_H32); float* H1 = (float*)(ws + WS_H1); float* U32 = (float*)(ws + WS_U);
    bf16* PROJ = (bf16*)(ws + WS_PROJ); float* XBCC = (float*)(ws + WS_XBCC); float* KMEAN = (float*)(ws + WS_KMEAN);
    float* YSSD = (float*)(ws + WS_YSSD); float* ATT = (float*)(ws + WS_ATT); bf16* MIX = (bf16*)(ws + WS_MIX);
    bf16* HUP = (bf16*)(ws + WS_HUP); bf16* ACT = (bf16*)(ws + WS_ACT); bf16* SG = (bf16*)(ws + WS_SG); bf16* PP = (bf16*)(ws + WS_PP);
    float* ROPE = (float*)(ws + WS_ROPE); bf16* PB = (bf16*)(ws + WS_PB);
    bf16* PART = (bf16*)(ws + WS_PART); float* PLSE = (float*)(ws + WS_PLSE); unsigned* LIST = (unsigned*)(ws + WS_LIST);
    float* STATES = (float*)(ws + WS_STATES); bf16* SIN = (bf16*)(ws + WS_SIN); float* LCS = (float*)(ws + WS_LCS); float* DEC = (float*)(ws + WS_DEC);

    if constexpr (PH == 0 || PH == -1) { PHASE_BEGIN();
        for (int L = 0; L < DEPTH; ++L) {
            unsigned char* wl = ws + WS_W + (size_t)L * SZ_WL;
            transpose_matrix(F, args.in[3] + (size_t)L * DM * NIN, DM, NIN, NINP, (bf16*)wl);
            transpose_matrix(F, args.in[11] + (size_t)L * DM * DM, DM, DM, DM, (bf16*)(wl + OFF_WOUT));
            transpose_matrix(F, args.in[14] + (size_t)L * DM * FF2, DM, FF2, FF2, (bf16*)(wl + OFF_WUP));
            transpose_matrix(F, args.in[17] + (size_t)L * FF * DM, FF, DM, DM, (bf16*)(wl + OFF_WDN));
            transpose_matrix(F, args.in[18] + (size_t)L * DM * DM, DM, DM, DM, (bf16*)(wl + OFF_WPG));
            transpose_matrix(F, args.in[19] + (size_t)L * PE * DM, PE, DM, DM, (bf16*)(wl + OFF_WPP));
        }
        cvt_rows(F, x_in, HB, (size_t)S_ * DM / 8);
        cvt_rows(F, args.in[1], PB, (size_t)DEPTH * S_ * PE / 8);
        {
            const int* pos = (const int*)args.in[2];
            for (int i = blockIdx.x * NTHR + F.tid; i < S_ * 16; i += F.G * NTHR) {
                const int t = i >> 4, k = i & 15;
                const float inv = (float)(1.0 / exp2((double)k * (18.931568569324174 / 16.0)));
                const float ang = (float)pos[t] * inv;
                const double rev = (double)ang * 0.15915494309189535; const float fr = (float)(rev - rint(rev));
                ROPE[t * 32 + k] = __builtin_amdgcn_cosf(fr); ROPE[t * 32 + 16 + k] = __builtin_amdgcn_sinf(fr);
            }
        }
        SEAM(0);
    }

    if constexpr (PH >= 1 || PH == -1)
    for (int L = (PH == -1 ? 0 : args.ph_lo); L < (PH == -1 ? DEPTH : args.ph_lo + 1); ++L) {
        const int fb = 0; (void)fb;
        unsigned char* wl = ws + WS_W + (size_t)L * SZ_WL;
        const float* hres = (L == 0) ? x_in : H32;

        if constexpr (PH == 1 || PH == -1) { PHASE_BEGIN();
            pg8::Gemm g{HB, (const bf16*)wl, S_, NINP, DM}; pg8::StaticOrder So; So.init(S_, NINP, F.G, (int)blockIdx.x);
            pg8::EpiB16<false> E{PROJ, NINP};
            pg8::gemm_phase<pg8::EpiB16<false>, pg8::StaticOrder, true, true>(F.lds, g, So, E);
            SEAM(fb + 0);
        }
        if constexpr (PH == 2 || PH == -1) { PHASE_BEGIN();
            LAS float* red = (LAS float*)F.lds;
            for (int u = blockIdx.x; u < 512; u += F.G) {
                const int which = u & 1, h = (u >> 1) & 7, blk = u >> 4;
                bf16* base = PROJ + (size_t)(blk * 256) * NINP + (which ? C_K : C_Q) + h * 128;
                if (which) {
                    const int col = F.tid & 127, rg = F.tid >> 7; float s = 0.f;
                    for (int r = rg * 64; r < rg * 64 + 64; ++r) {
                        float v = bf2f(base[(size_t)r * NINP + col]);
                        if (col < 32) { const float pv = bf2f(base[(size_t)r * NINP + (col ^ 16)]); const float* tb = ROPE + (size_t)(blk * 256 + r) * 32;
                            const float c = tb[col & 15], sn = tb[16 + (col & 15)]; v = (col < 16) ? v * c - pv * sn : v * c + pv * sn; }
                        s += v; }
                    red[rg * 128 + col] = s;
                    __syncthreads();
                    if (F.tid < 128) KMEAN[(size_t)(blk * 8 + h) * 128 + F.tid] = (red[F.tid] + red[128 + F.tid] + red[256 + F.tid] + red[384 + F.tid]) * (1.f / 256.f);
                }
                __syncthreads();
                for (int q = F.tid; q < 4096; q += NTHR) { const int r = q >> 4, i = q & 15; const float* tb = ROPE + (size_t)(blk * 256 + r) * 32;
                    const float c = tb[i], sn = tb[16 + i]; bf16* p1 = base + (size_t)r * NINP + i; const float t1 = bf2f(p1[0]), t2 = bf2f(p1[16]);
                    p1[0] = (bf16)f2bf(t1 * c - t2 * sn); p1[16] = (bf16)f2bf(t2 * c + t1 * sn); }
                __syncthreads();
            }
            SEAM(fb + 1);
        }
        if constexpr (PH == 3 || PH == -1) { PHASE_BEGIN();
            const float* cw = args.in[5] + (size_t)L * 4 * 1536; const float* cb = args.in[6] + (size_t)L * 1536;
            for (int i = blockIdx.x * NTHR + F.tid; i < S_ * 192; i += F.G * NTHR) {
                const int t = i / 192, c0 = (i % 192) * 8; float o[8];
#pragma unroll
                for (int j = 0; j < 8; ++j) o[j] = cb[c0 + j];
#pragma unroll
                for (int k = 0; k < 4; ++k) { const int tt = t - 3 + k; if (tt >= 0) { const v4u w = *(const v4u*)(PROJ + (size_t)tt * NINP + C_X + c0); const float* wk = cw + k * 1536 + c0;
                        o[0] += wk[0] * bflo(w.x); o[1] += wk[1] * bfhi(w.x); o[2] += wk[2] * bflo(w.y); o[3] += wk[3] * bfhi(w.y);
                        o[4] += wk[4] * bflo(w.z); o[5] += wk[5] * bfhi(w.z); o[6] += wk[6] * bflo(w.w); o[7] += wk[7] * bfhi(w.w); } }
                f32x4 a, b; a[0] = silu_f(o[0]); a[1] = silu_f(o[1]); a[2] = silu_f(o[2]); a[3] = silu_f(o[3]); b[0] = silu_f(o[4]); b[1] = silu_f(o[5]); b[2] = silu_f(o[6]); b[3] = silu_f(o[7]);
                *(f32x4*)(XBCC + (size_t)t * 1536 + c0) = a; *(f32x4*)(XBCC + (size_t)t * 1536 + c0 + 4) = b; }
            {
                unsigned* CNT = (unsigned*)ctl + CW_CNT + L * 256;
                for (int task = F.gw; task < 1024; task += F.NGW) {
                    const int h = task & 7, qt = task >> 3, qb = qt >> 2, lane = F.lane, sq = qt * 64 + lane;
                    if (qb == 0) continue;
                    float q[128];
                    { const v4u* qrow = (const v4u*)(PROJ + (size_t)sq * NINP + C_Q + h * 128);
#pragma unroll
                      for (int i = 0; i < 16; ++i) { const v4u w = qrow[i]; q[8 * i] = bflo(w.x); q[8 * i + 1] = bfhi(w.x); q[8 * i + 2] = bflo(w.y); q[8 * i + 3] = bfhi(w.y); q[8 * i + 4] = bflo(w.z); q[8 * i + 5] = bfhi(w.z); q[8 * i + 6] = bflo(w.w); q[8 * i + 7] = bfhi(w.w); } }
                    float v0 = -INFINITY, v1 = -INFINITY, v2 = -INFINITY; int i0 = 0, i1 = 0, i2 = 0;
#pragma unroll 1
                    for (int j = 0; j < qb; ++j) { const float* km = KMEAN + (size_t)(j * 8 + h) * 128; float g0 = 0.f, g1 = 0.f, g2 = 0.f, g3 = 0.f;
#pragma unroll
                        for (int d = 0; d < 128; d += 4) { g0 += q[d] * km[d]; g1 += q[d + 1] * km[d + 1]; g2 += q[d + 2] * km[d + 2]; g3 += q[d + 3] * km[d + 3]; }
                        const float gt = (g0 + g1) + (g2 + g3);
                        if (gt > v0) { v2 = v1; i2 = i1; v1 = v0; i1 = i0; v0 = gt; i0 = j; } else if (gt > v1) { v2 = v1; i2 = i1; v1 = gt; i1 = j; } else if (gt > v2) { v2 = gt; i2 = j; } }
                    const int nsel = qb < 3 ? qb : 3;
#pragma unroll 1
                    for (int j = 0; j < qb; ++j) { const int rk = (i0 == j) ? 0 : ((nsel > 1 && i1 == j) ? 1 : ((nsel > 2 && i2 == j) ? 2 : -1));
                        const unsigned long long mk = __ballot(rk >= 0);
                        if (mk) { const int cntj = __popcll(mk); unsigned base = 0; if (lane == (int)__builtin_ctzll(mk)) base = atomicAdd(&CNT[h * 32 + j], (unsigned)cntj);
                            base = (unsigned)__builtin_amdgcn_readlane((int)base, (int)__builtin_ctzll(mk));
                            if (rk >= 0) { const int pos = (int)base + __popcll(mk & ((1ull << lane) - 1ull)); LIST[((size_t)(h * 32 + j)) * 8192 + pos] = ((unsigned)sq << 2) | (unsigned)rk; } } }
                }
            }
            SEAM(fb + 2);
        }
        if constexpr (PH == 4 || PH == -1) { PHASE_BEGIN();
            {
                const LAS unsigned char* lB = F.lds + ssd::L_B; LAS float* ldt = (LAS float*)(F.lds + ssd::L_DT); LAS float* llc = (LAS float*)(F.lds + ssd::L_LC);
                const int lane = F.lane, w = F.wave, r = lane & 31, hh = lane >> 5;
                for (int u = blockIdx.x; u < 512; u += F.G) {
                    const int c = u >> 4, h = u & 15, g = h >> 3, t0 = c * 256;
                    const float a = -__expf(args.in[8][L * 16 + h]), dtb = args.in[7][L * 16 + h], Dh = args.in[9][L * 16 + h];
                    if (w == 0) {
                        float dv[4], cs[4]; float run = 0.f;
#pragma unroll
                        for (int j = 0; j < 4; ++j) { dv[j] = softplus_f(bf2f(PROJ[(size_t)(t0 + 4 * lane + j) * NINP + C_DT + h]) + dtb); run += dv[j] * a; cs[j] = run; }
                        float x = run;
#pragma unroll
                        for (int o = 1; o < 64; o <<= 1) { const float t = __shfl_up(x, o); if (lane >= o) x += t; }
                        const float excl = x - run;
#pragma unroll
                        for (int j = 0; j < 4; ++j) { ldt[4 * lane + j] = dv[j]; llc[4 * lane + j] = excl + cs[j]; }
                    }
#pragma unroll
                    for (int it = 0; it < 8; ++it) { const int idx = F.tid + NTHR * it, row = idx >> 4, ch = idx & 15; const float* src = XBCC + (size_t)(t0 + row) * 1536 + 1024 + g * 128 + ch * 8;
                        const f32x4 v0 = *(const f32x4*)src, v1 = *(const f32x4*)(src + 4); *(LAS bf16x8*)(F.lds + ssd::L_B + off_b(row, ch)) = pack8(v0, v1); }
                    __syncthreads();
                    {
                        const int sI = F.tid & 255, ph = F.tid >> 8; const float dts = ldt[sI], wend = dts * __expf(llc[255] - llc[sI]);
                        const float* xr = XBCC + (size_t)(t0 + sI) * 1536 + h * 64 + 32 * ph;
#pragma unroll
                        for (int q = 0; q < 8; ++q) { const f32x4 xv = *(const f32x4*)(xr + 4 * q);
#pragma unroll
                            for (int j = 0; j < 4; ++j) { const int p = 32 * ph + 4 * q + j;
                                *(LAS unsigned short*)(F.lds + ssd::L_X1 + p * ssd::XTP + 2 * sI) = (unsigned short)f2bf(dts * xv[j]);
                                *(LAS unsigned short*)(F.lds + ssd::L_X2 + p * ssd::XTP + 2 * sI) = (unsigned short)f2bf(wend * xv[j]); } }
                        if (F.tid < 256) LCS[(size_t)u * 256 + F.tid] = llc[F.tid];
                        if (F.tid == 0) DEC[u] = __expf(llc[255]);
                    }
                    bf16x8 cf[8];
                    { const float* cr = XBCC + (size_t)(t0 + 32 * w + r) * 1536 + 1280 + g * 128 + 8 * hh;
#pragma unroll
                      for (int k = 0; k < 8; ++k) { const f32x4 v0 = *(const f32x4*)(cr + 16 * k), v1 = *(const f32x4*)(cr + 16 * k + 4); cf[k] = pack8(v0, v1); } }
                    __syncthreads();
                    const float Ll = llc[32 * w + r];
                    f32x16 y0 = {}, y1 = {};
                    for (int st = 0; st <= w; ++st) {
                        f32x16 cb = {};
#pragma unroll
                        for (int k = 0; k < 8; ++k) { const bf16x8 af = *(const LAS bf16x8*)(lB + off_b(32 * st + r, 2 * k + hh)); cb = MFMA32(af, cf[k], cb); }
#pragma unroll
                        for (int q = 0; q < 4; ++q) { const f32x4 Ls = *(const LAS f32x4*)(llc + 32 * st + 8 * q + 4 * hh);
#pragma unroll
                            for (int j = 0; j < 4; ++j) { const float arg = fminf(Ll - Ls[j], 0.f); float v = cb[4 * q + j] * __expf(arg); if (st == w && (8 * q + 4 * hh + j) > r) v = 0.f; cb[4 * q + j] = v; } }
#pragma unroll
                        for (int sp = 0; sp < 2; ++sp) {
                            u32x4 pw; pw.x = cvtpk(cb[8 * sp + 0], cb[8 * sp + 1]); pw.y = cvtpk(cb[8 * sp + 2], cb[8 * sp + 3]); pw.z = cvtpk(cb[8 * sp + 4], cb[8 * sp + 5]); pw.w = cvtpk(cb[8 * sp + 6], cb[8 * sp + 7]);
                            const bf16x8 xs = __builtin_bit_cast(bf16x8, pw);
                            const LAS unsigned char* x1 = F.lds + ssd::L_X1 + r * ssd::XTP + 2 * (32 * st + 16 * sp + 4 * hh);
                            { const s16x4 lo = *(const LAS s16x4*)x1, hi = *(const LAS s16x4*)(x1 + 16); const bf16x8 a2 = __builtin_shufflevector(lo, hi, 0, 1, 2, 3, 4, 5, 6, 7); y0 = MFMA32(a2, xs, y0); }
                            { const s16x4 lo = *(const LAS s16x4*)(x1 + 32 * ssd::XTP), hi = *(const LAS s16x4*)(x1 + 32 * ssd::XTP + 16); const bf16x8 a2 = __builtin_shufflevector(lo, hi, 0, 1, 2, 3, 4, 5, 6, 7); y1 = MFMA32(a2, xs, y1); }
                        }
                    }
                    {
                        const size_t row = (size_t)(t0 + 32 * w + r); const float* xr = XBCC + row * 1536 + h * 64; float* yr = YSSD + row * 1024 + h * 64;
#pragma unroll
                        for (int q = 0; q < 4; ++q) { const int p0 = 8 * q + 4 * hh;
                            { const f32x4 xv = *(const f32x4*)(xr + p0); f32x4 o; o[0] = y0[4 * q] + Dh * xv[0]; o[1] = y0[4 * q + 1] + Dh * xv[1]; o[2] = y0[4 * q + 2] + Dh * xv[2]; o[3] = y0[4 * q + 3] + Dh * xv[3]; *(f32x4*)(yr + p0) = o; }
                            { const f32x4 xv = *(const f32x4*)(xr + 32 + p0); f32x4 o; o[0] = y1[4 * q] + Dh * xv[0]; o[1] = y1[4 * q + 1] + Dh * xv[1]; o[2] = y1[4 * q + 2] + Dh * xv[2]; o[3] = y1[4 * q + 3] + Dh * xv[3]; *(f32x4*)(yr + 32 + p0) = o; } }
                    }
                    {
                        const int pb = w >> 2, nb = w & 3, blk = (lane >> 4) & 1, q = (lane & 15) >> 2, pp = lane & 3; f32x16 sa = {};
#pragma unroll 4
                        for (int ks = 0; ks < 16; ++ks) {
                            const bf16x8 af = *(const LAS bf16x8*)(F.lds + ssd::L_X2 + (32 * pb + r) * ssd::XTP + 2 * (16 * ks + 8 * hh));
                            const s16x4 b0 = tr_rd(lB + off_b(16 * ks + 8 * hh + q, 4 * nb + 2 * blk + (pp >> 1)) + 8 * (pp & 1));
                            const s16x4 b1 = tr_rd(lB + off_b(16 * ks + 8 * hh + 4 + q, 4 * nb + 2 * blk + (pp >> 1)) + 8 * (pp & 1));
                            const bf16x8 bfv = __builtin_shufflevector(b0, b1, 0, 1, 2, 3, 4, 5, 6, 7);
                            sa = MFMA32(af, bfv, sa); }
                        float* so = STATES + (size_t)u * 8192 + (size_t)(32 * pb) * 128 + 32 * nb + r;
#pragma unroll
                        for (int rg = 0; rg < 16; ++rg) so[(size_t)crow(rg, hh) * 128] = sa[rg];
                    }
                    __syncthreads();
                }
            }
            {
                const unsigned* CNT = (const unsigned*)ctl + CW_CNT + L * 256;
                LAS int* pre = (LAS int*)(F.lds + att::L_PRE);
                if (F.tid < 64) { int run = 0;
                    int n[4];
#pragma unroll
                    for (int k = 0; k < 4; ++k) n[k] = ((int)__hip_atomic_load(&CNT[4 * F.lane + k], __ATOMIC_RELAXED, __HIP_MEMORY_SCOPE_AGENT) + 255) >> 8;
                    int tot = n[0] + n[1] + n[2] + n[3], x = tot;
#pragma unroll
                    for (int o = 1; o < 64; o <<= 1) { const int t = __shfl_up(x, o); if (F.lane >= o) x += t; }
                    run = x - tot;
#pragma unroll
                    for (int k = 0; k < 4; ++k) { pre[4 * F.lane + k] = run; run += n[k]; }
                    if (F.lane == 63) pre[256] = run; }
                __syncthreads();
                const int nsel_units = pre[256], total = nsel_units + 256; int li = 0;
                const int lane = F.lane, r32 = lane & 31, wv = F.wave;
                for (int u = blockIdx.x; u < total; u += F.G) {
                    if (u < nsel_units) {
                        while (pre[li + 1] <= u) ++li;
                        const int h = li >> 5, j = li & 31, chunk = u - pre[li]; const int n = (int)__hip_atomic_load(&CNT[li], __ATOMIC_RELAXED, __HIP_MEMORY_SCOPE_AGENT);
                        const int pos = chunk * 256 + wv * 32 + r32; const bool ok = pos < n;
                        const unsigned ent = ok ? LIST[(size_t)li * 8192 + pos] : (unsigned)(((j + 1) * 256) << 2);
                        const int sq = (int)(ent >> 2), slot = (int)(ent & 3u);
                        att::unit<false>(F.lds, PROJ, h, j * 256, sq, ok ? (sq * 8 + h) * 4 + slot : -1, PART, PLSE, F.tid);
                    } else {
                        const int v = u - nsel_units, h = v & 7, qb = v >> 3; const int sq = qb * 256 + wv * 32 + r32;
                        att::unit<true>(F.lds, PROJ, h, qb * 256, sq, (sq * 8 + h) * 4 + 3, PART, PLSE, F.tid);
                    }
                }
            }
            SEAM(fb + 3);
        }
        if constexpr (PH == 5 || PH == -1) { PHASE_BEGIN();
            for (int e = blockIdx.x * NTHR + F.tid; e < 16 * 8192; e += F.G * NTHR) {
                const int h = e >> 13, idx = e & 8191; float sv[32];
#pragma unroll
                for (int c = 0; c < 32; ++c) sv[c] = STATES[(size_t)(c * 16 + h) * 8192 + idx];
                float run = 0.f;
#pragma unroll
                for (int c = 0; c < 32; ++c) { SIN[(size_t)(c * 16 + h) * 8192 + idx] = (bf16)f2bf(run); run = DEC[c * 16 + h] * run + sv[c]; }
            }
            SEAM(fb + 4);
        }
        if constexpr (PH == 6 || PH == -1) { PHASE_BEGIN();
            const float* ag = args.in[4] + (size_t)L * 1024; const float* sgn = args.in[10] + (size_t)L * 1024;
            for (int t = F.gw; t < S_; t += F.NGW) { const int lane = F.lane, h = lane >> 3, c0 = 16 * (lane & 7), qb = t >> 8; const int nsel = qb < 3 ? qb : 3;
                const size_t pr = ((size_t)t * 8 + h) * 4; const f32x4 ls = *(const f32x4*)(PLSE + pr);
                float M = ls[3];
                if (nsel > 0) M = fmaxf(M, ls[0]); if (nsel > 1) M = fmaxf(M, ls[1]); if (nsel > 2) M = fmaxf(M, ls[2]);
                float wgt[4]; wgt[0] = nsel > 0 ? __builtin_amdgcn_exp2f(ls[0] - M) : 0.f; wgt[1] = nsel > 1 ? __builtin_amdgcn_exp2f(ls[1] - M) : 0.f; wgt[2] = nsel > 2 ? __builtin_amdgcn_exp2f(ls[2] - M) : 0.f; wgt[3] = __builtin_amdgcn_exp2f(ls[3] - M);
                const float iw = 1.f / ((wgt[0] + wgt[1]) + (wgt[2] + wgt[3]));
                float o[16];
#pragma unroll
                for (int i = 0; i < 16; ++i) o[i] = 0.f;
#pragma unroll
                for (int sl = 0; sl < 4; ++sl) { if (sl == 3 || sl < nsel) { const v4u* pp = (const v4u*)(PART + (pr + sl) * 128 + c0); const v4u a = pp[0], b = pp[1]; const float wv = wgt[sl] * iw;
                        o[0] += wv * bflo(a.x); o[1] += wv * bfhi(a.x); o[2] += wv * bflo(a.y); o[3] += wv * bfhi(a.y); o[4] += wv * bflo(a.z); o[5] += wv * bfhi(a.z); o[6] += wv * bflo(a.w); o[7] += wv * bfhi(a.w);
                        o[8] += wv * bflo(b.x); o[9] += wv * bfhi(b.x); o[10] += wv * bflo(b.y); o[11] += wv * bfhi(b.y); o[12] += wv * bflo(b.z); o[13] += wv * bfhi(b.z); o[14] += wv * bflo(b.w); o[15] += wv * bfhi(b.w); } }
                float ss = 0.f;
#pragma unroll
                for (int i = 0; i < 16; ++i) ss += o[i] * o[i];
                const float rs = 1.f / sqrtf(wave_sum(ss) * (1.f / 1024.f) + RMS_EPS);
                const float* gp = ag + h * 128 + c0; v4u w0, w1;
                w0.x = pk2(o[0] * rs * gp[0], o[1] * rs * gp[1]); w0.y = pk2(o[2] * rs * gp[2], o[3] * rs * gp[3]); w0.z = pk2(o[4] * rs * gp[4], o[5] * rs * gp[5]); w0.w = pk2(o[6] * rs * gp[6], o[7] * rs * gp[7]);
                w1.x = pk2(o[8] * rs * gp[8], o[9] * rs * gp[9]); w1.y = pk2(o[10] * rs * gp[10], o[11] * rs * gp[11]); w1.z = pk2(o[12] * rs * gp[12], o[13] * rs * gp[13]); w1.w = pk2(o[14] * rs * gp[14], o[15] * rs * gp[15]);
                v4u* mo = (v4u*)(MIX + (size_t)t * DM + h * 128 + c0); mo[0] = w0; mo[1] = w1;
            }
            {
                const int lane = F.lane, w = F.wave, r = lane & 31, hh = lane >> 5;
                for (int u = blockIdx.x; u < 64; u += F.G) {
                    const int c = u >> 1, g = u & 1, t0 = c * 256; const size_t row = (size_t)(t0 + 32 * w + r);
                    bf16x8 cf[8];
                    { const float* cr = XBCC + row * 1536 + 1280 + g * 128 + 8 * hh;
#pragma unroll
                      for (int k = 0; k < 8; ++k) { const f32x4 v0 = *(const f32x4*)(cr + 16 * k), v1 = *(const f32x4*)(cr + 16 * k + 4); cf[k] = pack8(v0, v1); } }
                    float ss = 0.f;
#pragma unroll 1
                    for (int e = 0; e < 8; ++e) { const int h = 8 * g + e; const size_t cu = (size_t)(c * 16 + h);
                        f32x16 a0 = {}, a1 = {};
                        const bf16* sp = SIN + cu * 8192 + (size_t)r * 128 + 8 * hh;
#pragma unroll
                        for (int k = 0; k < 8; ++k) { const bf16x8 s0 = *(const bf16x8*)(sp + 16 * k), s1 = *(const bf16x8*)(sp + 32 * 128 + 16 * k); a0 = MFMA32(s0, cf[k], a0); a1 = MFMA32(s1, cf[k], a1); }
                        const float el = __expf(LCS[cu * 256 + 32 * w + r]);
                        const float* yr = YSSD + row * 1024 + h * 64; const bf16* zr = PROJ + row * NINP + C_Z + h * 64; bf16* mr = MIX + row * DM + 1024 + h * 64;
#pragma unroll
                        for (int q = 0; q < 4; ++q) { const int p0 = 8 * q + 4 * hh;
                            { const f32x4 yv = *(const f32x4*)(yr + p0); const u32x2v zz = *(const u32x2v*)(zr + p0); f32x4 o;
                              o[0] = (yv[0] + el * a0[4 * q]) * silu_f(bflo(zz.x)); o[1] = (yv[1] + el * a0[4 * q + 1]) * silu_f(bfhi(zz.x)); o[2] = (yv[2] + el * a0[4 * q + 2]) * silu_f(bflo(zz.y)); o[3] = (yv[3] + el * a0[4 * q + 3]) * silu_f(bfhi(zz.y));
                              ss += (o[0] * o[0] + o[1] * o[1]) + (o[2] * o[2] + o[3] * o[3]); u32x2v wv; wv.x = pk2(o[0], o[1]); wv.y = pk2(o[2], o[3]); *(u32x2v*)(mr + p0) = wv; }
                            { const f32x4 yv = *(const f32x4*)(yr + 32 + p0); const u32x2v zz = *(const u32x2v*)(zr + 32 + p0); f32x4 o;
                              o[0] = (yv[0] + el * a1[4 * q]) * silu_f(bflo(zz.x)); o[1] = (yv[1] + el * a1[4 * q + 1]) * silu_f(bfhi(zz.x)); o[2] = (yv[2] + el * a1[4 * q + 2]) * silu_f(bflo(zz.y)); o[3] = (yv[3] + el * a1[4 * q + 3]) * silu_f(bfhi(zz.y));
                              ss += (o[0] * o[0] + o[1] * o[1]) + (o[2] * o[2] + o[3] * o[3]); u32x2v wv; wv.x = pk2(o[0], o[1]); wv.y = pk2(o[2], o[3]); *(u32x2v*)(mr + 32 + p0) = wv; } }
                    }
                    ss += __shfl_xor(ss, 32);
                    const float rstd = 1.f / sqrtf(ss * (1.f / 512.f) + RMS_EPS);
                    asm volatile("s_waitcnt vmcnt(0)" ::: "memory");
#pragma unroll 1
                    for (int e = 0; e < 8; ++e) { const int h = 8 * g + e; bf16* mr = MIX + row * DM + 1024 + h * 64; const float* gn = sgn + h * 64;
#pragma unroll
                        for (int q = 0; q < 8; ++q) { const int p0 = 32 * (q >> 2) + 8 * (q & 3) + 4 * hh; const u32x2v mv = *(const u32x2v*)(mr + p0); const f32x4 gg = *(const f32x4*)(gn + p0);
                            u32x2v wv; wv.x = pk2(bflo(mv.x) * rstd * gg[0], bfhi(mv.x) * rstd * gg[1]); wv.y = pk2(bflo(mv.y) * rstd * gg[2], bfhi(mv.y) * rstd * gg[3]); *(u32x2v*)(mr + p0) = wv; } }
                }
            }
            SEAM(fb + 4);
        }
        if constexpr (PH == 7 || PH == -1) { PHASE_BEGIN();
            pg8::Gemm g{MIX, (const bf16*)(wl + OFF_WOUT), S_, DM, DM}; pg8::StaticOrder So; So.init(S_, DM, F.G, (int)blockIdx.x);
            pg8::EpiResF32 E{U32, hres, DM, ALPHA};
            pg8::gemm_phase<pg8::EpiResF32, pg8::StaticOrder, true, true>(F.lds, g, So, E);
            SEAM(fb + 5);
        }
        if constexpr (PH == 8 || PH == -1) { PHASE_BEGIN();
            const float* g1 = args.in[12] + (size_t)L * DM; const float* b1 = args.in[13] + (size_t)L * DM;
            for (int t = F.gw; t < S_; t += F.NGW) ln_row(U32 + (size_t)t * DM, g1, b1, H1 + (size_t)t * DM, HB + (size_t)t * DM, F.lane);
            SEAM(fb + 6);
        }
        if constexpr (PH == 9 || PH == -1) { PHASE_BEGIN();
            pg8::Gemm g{HB, (const bf16*)(wl + OFF_WUP), S_, FF2, DM}; pg8::StaticOrder So; So.init(S_, FF2, F.G, (int)blockIdx.x);
            pg8::EpiB16<false> E{HUP, FF2};
            pg8::gemm_phase<pg8::EpiB16<false>, pg8::StaticOrder, true, true>(F.lds, g, So, E);
            SEAM(fb + 7);
        }
        if constexpr (PH == 10 || PH == -1) { PHASE_BEGIN();
            const float* cw = args.in[15] + (size_t)L * 3 * FF2; const float* cb = args.in[16] + (size_t)L * FF2;
            for (int i = blockIdx.x * NTHR + F.tid; i < S_ * (FF / 8); i += F.G * NTHR) {
                const int t = i / (FF / 8), c0 = (i % (FF / 8)) * 8; float og[8], ou[8];
#pragma unroll
                for (int j = 0; j < 8; ++j) { og[j] = cb[c0 + j]; ou[j] = cb[FF + c0 + j]; }
#pragma unroll
                for (int k = 0; k < 3; ++k) { const int tt = t - 2 + k; if (tt >= 0) { const v4u a = *(const v4u*)(HUP + (size_t)tt * FF2 + c0), b = *(const v4u*)(HUP + (size_t)tt * FF2 + FF + c0);
                        const float* wg = cw + (size_t)k * FF2 + c0; const float* wu = wg + FF;
                        og[0] += wg[0] * bflo(a.x); og[1] += wg[1] * bfhi(a.x); og[2] += wg[2] * bflo(a.y); og[3] += wg[3] * bfhi(a.y); og[4] += wg[4] * bflo(a.z); og[5] += wg[5] * bfhi(a.z); og[6] += wg[6] * bflo(a.w); og[7] += wg[7] * bfhi(a.w);
                        ou[0] += wu[0] * bflo(b.x); ou[1] += wu[1] * bfhi(b.x); ou[2] += wu[2] * bflo(b.y); ou[3] += wu[3] * bfhi(b.y); ou[4] += wu[4] * bflo(b.z); ou[5] += wu[5] * bfhi(b.z); ou[6] += wu[6] * bflo(b.w); ou[7] += wu[7] * bfhi(b.w); } }
                v4u o; o.x = pk2(silu_f(og[0]) * ou[0], silu_f(og[1]) * ou[1]); o.y = pk2(silu_f(og[2]) * ou[2], silu_f(og[3]) * ou[3]); o.z = pk2(silu_f(og[4]) * ou[4], silu_f(og[5]) * ou[5]); o.w = pk2(silu_f(og[6]) * ou[6], silu_f(og[7]) * ou[7]);
                *(v4u*)(ACT + (size_t)t * FF + c0) = o; }
            SEAM(fb + 8);
        }
        if constexpr (PH == 11 || PH == -1) { PHASE_BEGIN();
            { pg8::Gemm g{HB, (const bf16*)(wl + OFF_WPG), S_, DM, DM}; pg8::StaticOrder So; So.init(S_, DM, F.G, (int)blockIdx.x);
              pg8::EpiB16<true> E{SG, DM}; pg8::gemm_phase<pg8::EpiB16<true>, pg8::StaticOrder, true, true>(F.lds, g, So, E); }
            __syncthreads();
            { pg8::Gemm g{PB + (size_t)L * S_ * PE, (const bf16*)(wl + OFF_WPP), S_, DM, PE}; pg8::StaticOrder So; So.init(S_, DM, F.G, (int)blockIdx.x);
              pg8::EpiB16<false> E{PP, DM}; pg8::gemm_phase<pg8::EpiB16<false>, pg8::StaticOrder, true, true>(F.lds, g, So, E); }
            SEAM(fb + 9);
        }
        if constexpr (PH == 12 || PH == -1) { PHASE_BEGIN();
            pg8::Gemm g{ACT, (const bf16*)(wl + OFF_WDN), S_, DM, FF}; pg8::StaticOrder So; So.init(S_, DM, F.G, (int)blockIdx.x);
            pg8::EpiDown E{U32, H1, PP, SG, DM, ALPHA};
            pg8::gemm_phase<pg8::EpiDown, pg8::StaticOrder, true, true>(F.lds, g, So, E);
            SEAM(fb + 10);
        }
        if constexpr (PH == 13 || PH == -1) { PHASE_BEGIN();
            const float* g2 = args.in[20] + (size_t)L * DM; const float* b2 = args.in[21] + (size_t)L * DM;
            float* dst = (L == DEPTH - 1) ? args.out : H32;
            for (int t = F.gw; t < S_; t += F.NGW) ln_row(U32 + (size_t)t * DM, g2, b2, dst + (size_t)t * DM, HB + (size_t)t * DM, F.lane);
            if (L + 1 < DEPTH) SEAM(fb + 12);
        }
    }
#undef SEAM
}

#ifndef MK_ONE_LAUNCH
#define MK_ONE_LAUNCH 1
#endif
template <int PH> static void launch_ph(int grid, hipStream_t stream, const Args& a) { hipLaunchKernelGGL(fwd<PH>, dim3(grid), dim3(NTHR), LDS_BYTES, stream, a); }
template <int... I> static void launch_layer(int grid, hipStream_t stream, const Args& a, std::integer_sequence<int, I...>) { (launch_ph<I + 1>(grid, stream, a), ...); }
template <int... I> static void set_attrs(std::integer_sequence<int, I...>) { ((void)hipFuncSetAttribute((const void*)fwd<I>, hipFuncAttributeMaxDynamicSharedMemorySize, LDS_BYTES), ...); }
extern "C" void kernel_launch(void* const* d_in, const int* in_sizes, int n_in, void* d_out, int out_size, void* d_ws, size_t ws_size, hipStream_t stream) {
    static int grid = 0;
    if (grid == 0) {
        if (n_in != 22 || out_size != S_ * DM || ws_size < WS_END) { fprintf(stderr, "kernel_launch: unexpected shapes: n_in %d out %d ws %zu (need %zu)\n", n_in, out_size, ws_size, (size_t)WS_END); grid = -1; return; }
        int dev = 0, cus = 0, per_cu = 0;
        if (hipGetDevice(&dev) != hipSuccess || hipDeviceGetAttribute(&cus, hipDeviceAttributeMultiprocessorCount, dev) != hipSuccess) { grid = -1; return; }
        set_attrs(std::make_integer_sequence<int, NPH + 1>{});
        (void)hipFuncSetAttribute((const void*)fwd<-1>, hipFuncAttributeMaxDynamicSharedMemorySize, LDS_BYTES);
        (void)per_cu; (void)hipGetLastError();
        grid = cus;
    }
    if (grid < 0) return;
    (void)hipMemsetAsync(d_ws, 0, CTL_BYTES, stream);
    Args a{};
    for (int i = 0; i < 22; ++i) a.in[i] = (const float*)d_in[i];
    a.out = (float*)d_out; a.ws = (unsigned char*)d_ws;
    const int nflat = 1 + NPH * DEPTH;
    (void)nflat;
#if MK_ONE_LAUNCH
    a.ph_lo = 0; a.ph_hi = 0; launch_ph<-1>(grid, stream, a);
#else
    a.ph_lo = 0; a.ph_hi = 0; launch_ph<0>(grid, stream, a);
    for (int L = 0; L < DEPTH; ++L) { a.ph_lo = L; launch_layer(grid, stream, a, std::make_integer_sequence<int, NPH>{}); }
#endif
    const hipError_t le = hipPeekAtLastError();
    if (le != hipSuccess) fprintf(stderr, "kernel_launch: launch failed: %s\n", hipGetErrorName(le));
}
```
